# Optimizing an MI355X kernel written in HIP

```python
import math
import jax, jax.numpy as jnp
from jax import lax
import numpy as np

D_MODEL = 1024
BATCH = 1
SEQ = 16384
DEPTH = 1
DEC_BATCH = 32
DEC_SEQ = 4
PAST_LEN = 16384
PAGE_SIZE = 128

NSA_HEADS = 8
NSA_KV_HEADS = 2
NSA_GROUP = NSA_HEADS // NSA_KV_HEADS
NSA_HEAD_DIM = 64
CMP_BLOCK = 32
CMP_STRIDE = 16
CMP_HIDDEN = 2 * NSA_HEAD_DIM
SEL_BLOCK = 64
N_SEL = 16
WINDOW = 512
Q_BLOCK = 128
FORCE_BONUS = 1e4
N_BUCKETS = 32
MAX_DISTANCE = 128
HG_HEADS = 4
HG_KEY_DIM = 128
HG_VAL_DIM = 128
HG_CHUNK = 64
D_FF = ((8 * D_MODEL // 3 + 255) // 256) * 256
EPS = 1e-6

NSA_Q_DIM = NSA_HEADS * NSA_HEAD_DIM
NSA_KV_DIM = NSA_KV_HEADS * NSA_HEAD_DIM
HG_F_DIM = HG_HEADS * HG_KEY_DIM
HG_V_DIM = HG_HEADS * HG_VAL_DIM
IN_SIZES = (NSA_Q_DIM, NSA_KV_DIM, NSA_KV_DIM, NSA_KV_DIM, NSA_KV_DIM, NSA_KV_DIM, NSA_KV_DIM,
            3 * NSA_HEADS, HG_F_DIM, HG_F_DIM, HG_V_DIM, HG_V_DIM, D_MODEL, D_MODEL)
D_IN = sum(IN_SIZES)

kernel_name = 'nsa_hgrn2_gated_hybrid_step'


def rmsnorm(x, g):
    xf = x.astype(jnp.float32)
    y = xf * lax.rsqrt(jnp.mean(xf * xf, axis=-1, keepdims=True) + EPS) * g.astype(jnp.float32)
    return y.astype(x.dtype)


def masked_softmax(logits, mask):
    lf = jnp.where(mask, logits.astype(jnp.float32), -1e30)
    p = jax.nn.softmax(lf, axis=-1)
    return jnp.where(mask, p, 0.0)


def rel_bucket(rel):
    n = jnp.maximum(rel, 0)
    max_exact = N_BUCKETS // 2
    nf = jnp.maximum(n, 1).astype(jnp.float32)
    large = max_exact + (jnp.log(nf / max_exact) / math.log(MAX_DISTANCE / max_exact)
                         * (N_BUCKETS - max_exact)).astype(jnp.int32)
    large = jnp.minimum(large, N_BUCKETS - 1)
    return jnp.where(n < max_exact, n, large)


def project(xn, w_in):
    u = jnp.einsum('btd,de->bte', xn, w_in)
    parts, off = [], 0
    for n in IN_SIZES:
        parts.append(u[..., off:off + n])
        off += n
    return parts


def compress(rows, pe, w1, w2):
    B, L, KV, HD = rows.shape
    c = CMP_BLOCK // CMP_STRIDE
    nch = L // CMP_STRIDE
    nc = nch - c + 1
    ch = rows[:, :nch * CMP_STRIDE].reshape(B, nch, CMP_STRIDE, KV, HD)
    pe_r = pe.reshape(c, CMP_STRIDE, HD)
    w1_r = w1.reshape(c, CMP_STRIDE, HD, CMP_HIDDEN)
    h = jnp.einsum('bnskd,sde->bnke', ch[:, 0:nc] + pe_r[0][:, None, :], w1_r[0])
    for j in range(1, c):
        h = h + jnp.einsum('bnskd,sde->bnke', ch[:, j:j + nc] + pe_r[j][:, None, :], w1_r[j])
    blocks = jnp.einsum('bnke,ed->bnkd', jax.nn.gelu(h), w2)
    end_pos = jnp.arange(nc, dtype=jnp.int32) * CMP_STRIDE + (CMP_BLOCK - 1)
    return blocks, end_pos


def sel_blocks(rows):
    B, L, KV, HD = rows.shape
    nb = -(-L // SEL_BLOCK)
    rows = jnp.pad(rows, ((0, 0), (0, nb * SEL_BLOCK - L), (0, 0), (0, 0)))
    return rows.reshape(B, nb, SEL_BLOCK, KV, HD).transpose(0, 3, 1, 2, 4)


def nsa_attend(q, gates, q_pos, kc, vc, c_end, ks_t, vs_t, kw, vw, kw_pos, rel_bias):
    B, QB = q.shape[:2]
    KV, G, HD = NSA_KV_HEADS, NSA_GROUP, NSA_HEAD_DIM
    qg = (q * HD ** -0.5).reshape(B, QB, KV, G, HD).transpose(0, 2, 3, 1, 4)
    tbl = rel_bias.T.reshape(KV, G, N_BUCKETS)
    rel_c = q_pos[:, None] - c_end[None, :]
    logit_c = jnp.einsum('bkgqd,bnkd->bkgqn', qg, kc) + tbl[:, :, rel_bucket(rel_c)]
    p_c = masked_softmax(logit_c, rel_c >= 0)
    o_c = jnp.einsum('bkgqn,bnkd->bkgqd', p_c.astype(vc.dtype), vc)
    nc = kc.shape[1]
    nb = ks_t.shape[2]
    c = CMP_BLOCK // CMP_STRIDE
    ratio = SEL_BLOCK // CMP_STRIDE
    n_ov = ratio + c - 1
    imp = p_c.sum(axis=2)
    right = max(0, ratio * (nb - 1) + n_ov - (c - 1) - nc)
    imp = jnp.pad(imp, ((0, 0), (0, 0), (0, 0), (c - 1, right)))
    score = jnp.zeros(imp.shape[:3] + (nb,), jnp.float32)
    for u in range(n_ov):
        start = CMP_STRIDE * (u - (c - 1))
        w_u = (min(start + CMP_BLOCK, SEL_BLOCK) - max(start, 0)) / CMP_STRIDE
        score = score + w_u * imp[..., u:u + ratio * (nb - 1) + 1:ratio]
    blk = jnp.arange(nb, dtype=jnp.int32)[None, :]
    cur = (q_pos // SEL_BLOCK)[:, None]
    forced = (blk == 0) | (blk == cur) | (blk == cur - 1)
    score = jnp.where(blk <= cur, score + jnp.where(forced, FORCE_BONUS, 0.0), -FORCE_BONUS)
    n_sel = min(N_SEL, nb)
    _, idx = lax.top_k(score, n_sel)
    bi = jnp.arange(B)[:, None, None, None]
    ki = jnp.arange(KV)[None, :, None, None]
    nk = n_sel * SEL_BLOCK
    ksel = ks_t[bi, ki, idx].reshape(B, KV, QB, nk, HD)
    vsel = vs_t[bi, ki, idx].reshape(B, KV, QB, nk, HD)
    spos = (idx[..., None] * SEL_BLOCK + jnp.arange(SEL_BLOCK, dtype=jnp.int32)).reshape(B, KV, QB, nk)
    rel_s = q_pos[None, None, :, None] - spos
    kk = jnp.arange(KV)[None, :, None, None, None]
    gg = jnp.arange(G)[None, None, :, None, None]
    logit_s = jnp.einsum('bkgqd,bkqnd->bkgqn', qg, ksel) + tbl[kk, gg, rel_bucket(rel_s)[:, :, None]]
    p_s = masked_softmax(logit_s, (rel_s >= 0)[:, :, None])
    o_s = jnp.einsum('bkgqn,bkqnd->bkgqd', p_s.astype(vsel.dtype), vsel)
    rel_w = q_pos[:, None] - kw_pos[None, :]
    mask_w = (rel_w >= 0) & (rel_w < WINDOW) & (kw_pos[None, :] >= 0)
    logit_w = jnp.einsum('bkgqd,bnkd->bkgqn', qg, kw) + tbl[:, :, rel_bucket(rel_w)]
    p_w = masked_softmax(logit_w, mask_w)
    o_w = jnp.einsum('bkgqn,bnkd->bkgqd', p_w.astype(vw.dtype), vw)
    gt = gates.reshape(B, QB, KV, G, 3).transpose(0, 2, 3, 1, 4)
    o = gt[..., 0:1] * o_c + gt[..., 1:2] * o_s + gt[..., 2:3] * o_w
    return o.transpose(0, 3, 1, 2, 4).reshape(B, QB, KV * G * HD)


def nsa_prompt(q, gates, kc, vc, c_end, ks_t, vs_t, kw, vw, rel_bias):
    B, T = q.shape[:2]
    KV, HD = NSA_KV_HEADS, NSA_HEAD_DIM
    qb_len = min(Q_BLOCK, T)
    nqb = T // qb_len
    nwb = -(-WINDOW // qb_len)
    padw = nwb * qb_len
    qb = q.reshape(B, nqb, qb_len, NSA_HEADS, HD).swapaxes(0, 1)
    gb = gates.reshape(B, nqb, qb_len, NSA_HEADS, 3).swapaxes(0, 1)
    posb = jnp.arange(T, dtype=jnp.int32).reshape(nqb, qb_len)

    def band(a):
        ap = jnp.pad(a, ((0, 0), (padw, 0), (0, 0), (0, 0))).reshape(B, nqb + nwb, qb_len, KV, HD)
        return jnp.concatenate([ap[:, i:i + nqb] for i in range(nwb + 1)], axis=2).swapaxes(0, 1)

    band_pos = (jnp.arange(nqb, dtype=jnp.int32)[:, None] * qb_len - padw
                + jnp.arange((nwb + 1) * qb_len, dtype=jnp.int32)[None, :])

    def block(args):
        qq, ga, pp, kb, vb, kp = args
        return nsa_attend(qq, ga, pp, kc, vc, c_end, ks_t, vs_t, kb, vb, kp, rel_bias)

    o = lax.map(block, (qb, gb, posb, band(kw), band(vw), band_pos))
    return o.swapaxes(0, 1).reshape(B, T, NSA_Q_DIM)


def hgrn_scan(q, k, v, log_f, S0):
    B, T, H, DK = q.shape
    DV = v.shape[-1]
    C = min(HG_CHUNK, T)
    nc = -(-T // C)
    pad = nc * C - T

    def prep(a):
        a = jnp.pad(a.astype(jnp.float32), ((0, 0), (0, pad), (0, 0), (0, 0)))
        return a.reshape(B, nc, C, H, a.shape[-1]).transpose(1, 0, 3, 2, 4)

    tri = (jnp.arange(C)[:, None] >= jnp.arange(C)[None, :])[:, :, None]

    def step(S, inp):
        qc, kc, vc, lfc = inp
        b = jnp.cumsum(lfc, axis=2)
        inter = jnp.einsum('bhtk,bhkv->bhtv', qc * jnp.exp(b), S)
        diff = b[:, :, :, None, :] - b[:, :, None, :, :]
        decay = jnp.exp(jnp.where(tri, diff, -jnp.inf))
        A = jnp.einsum('bhtk,bhtsk,bhsk->bhts', qc, decay, kc)
        intra = jnp.einsum('bhts,bhsv->bhtv', A, vc)
        bl = b[:, :, -1:, :]
        S_new = jnp.exp(bl[:, :, 0])[..., None] * S + jnp.einsum('bhsk,bhsv->bhkv', kc * jnp.exp(bl - b), vc)
        return S_new, inter + intra

    S, o = lax.scan(step, S0.astype(jnp.float32), (prep(q), prep(k), prep(v), prep(log_f)))
    o = o.transpose(1, 0, 3, 2, 4).reshape(B, nc * C, H, DV)[:, :T]
    return o, S


def hgrn_mix(q_raw, f_raw, i_raw, g_raw, lb, g_norm, S0):
    B, T, _ = q_raw.shape
    sh = lambda a, d: a.reshape(B, T, HG_HEADS, d).astype(jnp.float32)
    lbh = lb.reshape(HG_HEADS, HG_KEY_DIM)
    z = sh(f_raw, HG_KEY_DIM)
    q = jax.nn.silu(sh(q_raw, HG_KEY_DIM))
    log_f = jnp.logaddexp(jnp.log(lbh), jnp.log1p(-lbh) + jax.nn.log_sigmoid(z))
    k = (1.0 - lbh) * jax.nn.sigmoid(-z)
    v = sh(i_raw, HG_VAL_DIM)
    o, S = hgrn_scan(q, k, v, log_f, S0)
    o = rmsnorm(o, g_norm) * jax.nn.silu(sh(g_raw, HG_VAL_DIM))
    return o.reshape(B, T, HG_V_DIM).astype(q_raw.dtype), S


def layer_forward(x, pos0, past, norm_mix, w_in, cmp_pe_k, cmp_w1_k, cmp_w2_k, cmp_pe_v, cmp_w1_v, cmp_w2_v,
                  rel_bias, lb, hg_norm, w_proj_a, w_proj_b, w_out, norm_ffn, w_gate, w_up, w_down):
    B, T, _ = x.shape
    q_pos = pos0 + jnp.arange(T, dtype=jnp.int32)
    xn = rmsnorm(x, norm_mix)
    (q_a, kc_r, vc_r, ks_r, vs_r, kw_r, vw_r, g_a, q_b, f_b, i_b, g_b, gate_a, gate_b) = project(xn, w_in)
    kvh = lambda a: a.reshape(B, T, NSA_KV_HEADS, NSA_HEAD_DIM)
    kc_r, vc_r, ks_r, vs_r, kw_r, vw_r = kvh(kc_r), kvh(vc_r), kvh(ks_r), kvh(vs_r), kvh(kw_r), kvh(vw_r)
    q_a = q_a.reshape(B, T, NSA_HEADS, NSA_HEAD_DIM)
    g_a = jax.nn.sigmoid(g_a.reshape(B, T, NSA_HEADS, 3))
    if past is None:
        kc_all, vc_all, ks_all, vs_all = kc_r, vc_r, ks_r, vs_r
        S0 = jnp.zeros((B, HG_HEADS, HG_KEY_DIM, HG_VAL_DIM), jnp.float32)
    else:
        pk_c, pv_c, pk_s, pv_s, buf_k, buf_v, S0 = past
        kc_all = jnp.concatenate([pk_c, kc_r], axis=1)
        vc_all = jnp.concatenate([pv_c, vc_r], axis=1)
        ks_all = jnp.concatenate([pk_s, ks_r], axis=1)
        vs_all = jnp.concatenate([pv_s, vs_r], axis=1)
    kc, c_end = compress(kc_all, cmp_pe_k, cmp_w1_k, cmp_w2_k)
    vc, _ = compress(vc_all, cmp_pe_v, cmp_w1_v, cmp_w2_v)
    ks_t, vs_t = sel_blocks(ks_all), sel_blocks(vs_all)
    if past is None:
        o_a = nsa_prompt(q_a, g_a, kc, vc, c_end, ks_t, vs_t, kw_r, vw_r, rel_bias)
        wl = min(WINDOW, T)
        win_k, win_v = kw_r[:, -wl:], vw_r[:, -wl:]
    else:
        W = buf_k.shape[1]
        kw = jnp.concatenate([buf_k, kw_r], axis=1)
        vw = jnp.concatenate([buf_v, vw_r], axis=1)
        kw_pos = pos0 - W + jnp.arange(W + T, dtype=jnp.int32)
        o_a = nsa_attend(q_a, g_a, q_pos, kc, vc, c_end, ks_t, vs_t, kw, vw, kw_pos, rel_bias)
        win_k, win_v = kw[:, -W:], vw[:, -W:]
    o_b, S = hgrn_mix(q_b, f_b, i_b, g_b, lb, hg_norm, S0)
    merged = (jax.nn.sigmoid(gate_a) * jnp.einsum('bte,ed->btd', o_a, w_proj_a)
              + jax.nn.sigmoid(gate_b) * jnp.einsum('bte,ed->btd', o_b, w_proj_b))
    x = x + jnp.einsum('btd,de->bte', merged, w_out)
    hn = rmsnorm(x, norm_ffn)
    ff = jax.nn.silu(jnp.einsum('btd,df->btf', hn, w_gate)) * jnp.einsum('btd,df->btf', hn, w_up)
    x = x + jnp.einsum('btf,fd->btd', ff, w_down)
    return x, (kc_r, vc_r, ks_r, vs_r, win_k, win_v, S)


def setup_inputs(seed: int = 0) -> dict:
    key = jax.random.key(seed)
    ks = jax.random.split(key, 32)
    f32 = jnp.float32
    nrm = lambda k, shape, s=1.0: s * jax.random.normal(k, shape, f32)
    n_pages = PAST_LEN // PAGE_SIZE
    n_pool = (5 * DEC_BATCH * n_pages + 3) // 4
    w_buf = min(WINDOW, PAST_LEN)
    pool_shape = (DEPTH, n_pool, PAGE_SIZE, NSA_KV_HEADS, NSA_HEAD_DIM)
    win_shape = (DEPTH, DEC_BATCH, w_buf, NSA_KV_HEADS, NSA_HEAD_DIM)
    page_table = jax.random.permutation(ks[9], n_pool)[:DEC_BATCH * n_pages].reshape(DEC_BATCH, n_pages).astype(jnp.int32)
    hd = NSA_HEAD_DIM
    return {
        'x_prompt': nrm(ks[0], (BATCH, SEQ, D_MODEL)),
        'x_sample': nrm(ks[1], (DEC_BATCH, DEC_SEQ, D_MODEL)),
        'cache_k_cmp': nrm(ks[2], pool_shape),
        'cache_v_cmp': nrm(ks[3], pool_shape),
        'cache_k_slc': nrm(ks[4], pool_shape),
        'cache_v_slc': nrm(ks[5], pool_shape),
        'state_k_win': nrm(ks[6], win_shape),
        'state_v_win': nrm(ks[7], win_shape),
        'state_hgrn': nrm(ks[8], (DEPTH, DEC_BATCH, HG_HEADS, HG_KEY_DIM, HG_VAL_DIM), 0.5),
        'page_table': page_table,
        'norm_mix': 1.0 + nrm(ks[10], (DEPTH, D_MODEL), 0.1),
        'w_in': nrm(ks[11], (DEPTH, D_MODEL, D_IN), D_MODEL ** -0.5),
        'cmp_pe_k': nrm(ks[12], (DEPTH, CMP_BLOCK, hd), 0.1),
        'cmp_w1_k': nrm(ks[13], (DEPTH, CMP_BLOCK, hd, CMP_HIDDEN), (CMP_BLOCK * hd) ** -0.5),
        'cmp_w2_k': nrm(ks[14], (DEPTH, CMP_HIDDEN, hd), CMP_HIDDEN ** -0.5),
        'cmp_pe_v': nrm(ks[15], (DEPTH, CMP_BLOCK, hd), 0.1),
        'cmp_w1_v': nrm(ks[16], (DEPTH, CMP_BLOCK, hd, CMP_HIDDEN), (CMP_BLOCK * hd) ** -0.5),
        'cmp_w2_v': nrm(ks[17], (DEPTH, CMP_HIDDEN, hd), CMP_HIDDEN ** -0.5),
        'rel_bias': nrm(ks[18], (N_BUCKETS, NSA_HEADS), 0.5),
        'hg_lb_logits': nrm(ks[19], (DEPTH + 1, HG_F_DIM)),
        'hg_norm': 1.0 + nrm(ks[20], (DEPTH, HG_VAL_DIM), 0.1),
        'w_proj_a': nrm(ks[21], (DEPTH, NSA_Q_DIM, D_MODEL), NSA_Q_DIM ** -0.5),
        'w_proj_b': nrm(ks[22], (DEPTH, HG_V_DIM, D_MODEL), HG_V_DIM ** -0.5),
        'w_out': nrm(ks[23], (DEPTH, D_MODEL, D_MODEL), D_MODEL ** -0.5),
        'norm_ffn': 1.0 + nrm(ks[24], (DEPTH, D_MODEL), 0.1),
        'w_gate': nrm(ks[25], (DEPTH, D_MODEL, D_FF), D_MODEL ** -0.5),
        'w_up': nrm(ks[26], (DEPTH, D_MODEL, D_FF), D_MODEL ** -0.5),
        'w_down': nrm(ks[27], (DEPTH, D_FF, D_MODEL), D_FF ** -0.5),
        'norm_final': 1.0 + nrm(ks[28], (D_MODEL,), 0.1),
    }


def reference(x_prompt, x_sample, cache_k_cmp, cache_v_cmp, cache_k_slc, cache_v_slc, state_k_win, state_v_win,
              state_hgrn, page_table, norm_mix, w_in, cmp_pe_k, cmp_w1_k, cmp_w2_k, cmp_pe_v, cmp_w1_v, cmp_w2_v,
              rel_bias, hg_lb_logits, hg_norm, w_proj_a, w_proj_b, w_out, norm_ffn, w_gate, w_up, w_down, norm_final):
    lbs = jnp.cumsum(jax.nn.softmax(hg_lb_logits.astype(jnp.float32), axis=0), axis=0)
    dec_b, n_pages = page_table.shape
    past_len = n_pages * cache_k_cmp.shape[2]

    def gather(pool):
        return pool[page_table].reshape(dec_b, past_len, NSA_KV_HEADS, NSA_HEAD_DIM)

    xp, xs = x_prompt, x_sample
    new_p, new_s = [], []
    for l in range(DEPTH):
        lw = (norm_mix[l], w_in[l], cmp_pe_k[l], cmp_w1_k[l], cmp_w2_k[l], cmp_pe_v[l], cmp_w1_v[l], cmp_w2_v[l],
              rel_bias, lbs[l], hg_norm[l], w_proj_a[l], w_proj_b[l], w_out[l], norm_ffn[l], w_gate[l], w_up[l], w_down[l])
        xp, sp = layer_forward(xp, 0, None, *lw)
        past = (gather(cache_k_cmp[l]), gather(cache_v_cmp[l]), gather(cache_k_slc[l]), gather(cache_v_slc[l]),
                state_k_win[l], state_v_win[l], state_hgrn[l])
        xs, ss = layer_forward(xs, past_len, past, *lw)
        new_p.append(sp)
        new_s.append(ss)
    y_prompt = rmsnorm(xp, norm_final)
    y_sample = rmsnorm(xs, norm_final)
    p_k_cmp, p_v_cmp, p_k_slc, p_v_slc, p_k_win, p_v_win, p_hgrn = [jnp.stack(z) for z in zip(*new_p)]
    s_k_cmp, s_v_cmp, s_k_slc, s_v_slc, s_k_win, s_v_win, s_hgrn = [jnp.stack(z) for z in zip(*new_s)]
    return (y_prompt, y_sample, p_k_cmp, p_v_cmp, p_k_slc, p_v_slc, p_k_win, p_v_win, p_hgrn,
            s_k_cmp, s_v_cmp, s_k_slc, s_v_slc, s_k_win, s_v_win, s_hgrn)
```

```cpp
#include <hip/hip_runtime.h>
#include <cstdio>
#include <cstdint>
namespace pg8 {
#define PG8_LAS __attribute__((address_space(3)))
typedef unsigned short bf16_t;
typedef short bf16x8 __attribute__((ext_vector_type(8)));
typedef float f32x4 __attribute__((ext_vector_type(4)));
typedef unsigned u32x4 __attribute__((ext_vector_type(4)));
constexpr int BM = 256, BK = 64, HALF = 128, HTB = HALF * BK * 2  , STAGE_BYTES = 8 * HTB, NXCD = 8, WGM = 8;

__host__ __device__ __forceinline__ int lds_byte(int r, int c) { const int st = (r >> 4) * 2 + (c >> 5), rr = r & 15, cc = c & 31, ob = rr * 64 + cc * 2; return st * 1024 + (ob ^ (((ob >> 9) & 1) << 5)); }
__host__ __device__ __forceinline__ void stage_rc(int b, int& R, int& C) { const int st = b / 1024, sb = b % 1024, swz = sb ^ (((sb >> 9) & 1) << 5); R = (st >> 1) * 16 + swz / 64; C = (st & 1) * 32 + (swz % 64) / 2; }
__host__ __device__ __forceinline__ int perm32(int rho) { const int n = rho >> 4, i = rho & 15; return 8 * (i >> 2) + 4 * n + (i & 3); }

struct Unit { int pm, pn, gi; };

__device__ __forceinline__ unsigned cvt_pk_bf16(float lo, float hi) { unsigned r; asm volatile("v_cvt_pk_bf16_f32 %0, %1, %2" : "=v"(r) : "v"(lo), "v"(hi)); return r; }

template <class Epi, class Sched, bool ALIGN_EPI = false, bool SP2 = false>
__device__ __forceinline__ void gemm_phase(PG8_LAS unsigned char* lds, const int Kdim, const Sched& S, const Epi& E) {
    int tid_ = threadIdx.x; asm volatile("" : "+v"(tid_));
    const int tid = tid_, wid = __builtin_amdgcn_readfirstlane(tid >> 6), lane = tid & 63, wr = wid >> 2, wc = wid & 3, fr = lane & 15, fq = lane >> 4;
    const int K = Kdim, nt = K / BK;
    unsigned voffA[2], voffB[2];
#pragma unroll
    for (int i = 0; i < 2; ++i) { int R, C; stage_rc(tid * 16 + i * 8192, R, C); const int Rb = Epi::PERM ? ((R & ~31) + perm32(R & 31)) : R;
        voffA[i] = (unsigned)(R * K + C) * 2u; voffB[i] = (unsigned)(Rb * K + C) * 2u; }
    const size_t kstep = (size_t)(BK * 2);
    const size_t hstep = (size_t)HALF * K * 2;
    const unsigned ldsw = (unsigned)wid * 1024u;
    const int aoff = lds_byte(wr * 64 + fr, fq * 8), boff = lds_byte(wc * 32 + fr, fq * 8);
#define PG8_SA(b, h) (((b) * 2 + (h)) * HTB)
#define PG8_SB(b, h) ((4 + (b) * 2 + (h)) * HTB)
#define PG8_STAGE(bufoff, gbase, voff) do { _Pragma("unroll") for (int _i = 0; _i < 2; ++_i) \
        __builtin_amdgcn_global_load_lds((const unsigned*)((const char*)(gbase) + (voff)[_i]), (PG8_LAS unsigned*)(lds + (bufoff) + ldsw + _i * 8192), 16, 0, 0); } while (0)
#define PG8_LDA(dst, b, h) do { _Pragma("unroll") for (int m = 0; m < 4; ++m) _Pragma("unroll") for (int k = 0; k < 2; ++k) dst[m][k] = *(const PG8_LAS bf16x8*)(lds + PG8_SA(b, h) + aoff + m * 2048 + k * 1024); } while (0)
#define PG8_LDB(dst, b, h) do { _Pragma("unroll") for (int n = 0; n < 2; ++n) _Pragma("unroll") for (int k = 0; k < 2; ++k) dst[n][k] = *(const PG8_LAS bf16x8*)(lds + PG8_SB(b, h) + boff + n * 2048 + k * 1024); } while (0)
#define PG8_MMA(ai, bj, At, Bt) do { __builtin_amdgcn_s_setprio(1); _Pragma("unroll") for (int m = 0; m < 4; ++m) _Pragma("unroll") for (int n = 0; n < 2; ++n) _Pragma("unroll") for (int k = 0; k < 2; ++k) \
        acc[ai][bj][m][n] = __builtin_amdgcn_mfma_f32_16x16x32_bf16(Bt[n][k], At[m][k], acc[ai][bj][m][n], 0, 0, 0); __builtin_amdgcn_s_setprio(0); } while (0)
#define PG8_WAIT_V(n) asm volatile("s_waitcnt vmcnt(" #n ")" ::: "memory")
#define PG8_WAIT_L(n) asm volatile("s_waitcnt lgkmcnt(" #n ")" ::: "memory")
#define PG8_BAR __builtin_amdgcn_s_barrier()
#define PG8_SCHED __builtin_amdgcn_sched_barrier(0)
    Unit cur, nxt; int ui = 0;
    if (!S.next(0, cur)) return;
    f32x4 acc[2][2][4][2];
#pragma unroll
    for (int a = 0; a < 2; ++a)
#pragma unroll
        for (int b = 0; b < 2; ++b)
#pragma unroll
            for (int m = 0; m < 4; ++m)
#pragma unroll
                for (int n = 0; n < 2; ++n) acc[a][b][m][n] = (f32x4){0.f, 0.f, 0.f, 0.f};
    bf16x8 At[4][2], B0[2][2], B1[2][2];
    const char* cA; const char* cB; S.ptrs(cur, cA, cB);
    S.a_ready(cur);
    if constexpr (SP2) {
        PG8_STAGE(PG8_SB(0, 0), cB, voffB); PG8_STAGE(PG8_SB(0, 1), cB + hstep, voffB); PG8_STAGE(PG8_SA(0, 0), cA, voffA); PG8_STAGE(PG8_SA(0, 1), cA + hstep, voffA);
        if (wr == 1) PG8_BAR;
        PG8_WAIT_V(2); PG8_BAR;
        PG8_STAGE(PG8_SB(1, 0), cB + kstep, voffB); PG8_STAGE(PG8_SA(1, 0), cA + kstep, voffA); PG8_STAGE(PG8_SB(1, 1), cB + hstep + kstep, voffB);
        PG8_WAIT_V(6); PG8_BAR;
    } else {
        PG8_STAGE(PG8_SB(0, 0), cB, voffB); PG8_STAGE(PG8_SA(0, 0), cA, voffA); PG8_STAGE(PG8_SB(0, 1), cB + hstep, voffB); PG8_STAGE(PG8_SA(0, 1), cA + hstep, voffA);
        if (wr == 1) PG8_BAR;
        PG8_WAIT_V(4); PG8_BAR;
        PG8_STAGE(PG8_SB(1, 0), cB + kstep, voffB); PG8_STAGE(PG8_SA(1, 0), cA + kstep, voffA); PG8_STAGE(PG8_SB(1, 1), cB + hstep + kstep, voffB);
        PG8_WAIT_V(6); PG8_BAR;
    }
    for (;;) {
        const bool has_next = S.next(ui + 1, nxt);
        const char* nA = cA; const char* nB = cB; if (has_next) S.ptrs(nxt, nA, nB);
        for (int t = 0; t < nt; t += 2) {
            const bool last = (t == nt - 2);
            const char* a1 = cA + (size_t)(t + 1) * kstep;
            const char* a2 = last ? nA : cA + (size_t)(t + 2) * kstep; const char* b2 = last ? nB : cB + (size_t)(t + 2) * kstep;
            const char* a3 = a2 + kstep; const char* b3 = b2 + kstep;
            if (last && has_next) S.a_ready(nxt);
            if constexpr (SP2) {
            PG8_LDB(B0, 0, 0); PG8_LDB(B1, 0, 1); PG8_SCHED; PG8_LDA(At, 0, 0); PG8_STAGE(PG8_SA(1, 1), a1 + hstep, voffA);
            PG8_WAIT_V(8); PG8_WAIT_L(0); PG8_BAR; PG8_MMA(0, 0, At, B0); PG8_MMA(0, 1, At, B1); PG8_BAR; PG8_SCHED;
            PG8_LDA(At, 0, 1); PG8_STAGE(PG8_SB(0, 0), b2, voffB); PG8_STAGE(PG8_SB(0, 1), b2 + hstep, voffB); PG8_STAGE(PG8_SA(0, 0), a2, voffA);
            PG8_WAIT_V(8); PG8_WAIT_L(0); PG8_BAR; PG8_MMA(1, 0, At, B0); PG8_MMA(1, 1, At, B1); PG8_BAR; PG8_SCHED;
            PG8_LDB(B0, 1, 0); PG8_LDB(B1, 1, 1); PG8_SCHED; PG8_LDA(At, 1, 0); PG8_STAGE(PG8_SA(0, 1), a2 + hstep, voffA);
            PG8_WAIT_V(8); PG8_WAIT_L(0); PG8_BAR; PG8_MMA(0, 0, At, B0); PG8_MMA(0, 1, At, B1); PG8_BAR; PG8_SCHED;
            PG8_LDA(At, 1, 1); PG8_STAGE(PG8_SB(1, 0), b3, voffB); PG8_STAGE(PG8_SB(1, 1), b3 + hstep, voffB); PG8_STAGE(PG8_SA(1, 0), a3, voffA);
            PG8_WAIT_V(8); PG8_WAIT_L(0); PG8_BAR; PG8_MMA(1, 0, At, B0); PG8_MMA(1, 1, At, B1); PG8_BAR; PG8_SCHED;
            } else {
            PG8_LDB(B0, 0, 0); PG8_SCHED; PG8_LDA(At, 0, 0); PG8_STAGE(PG8_SA(1, 1), a1 + hstep, voffA);
            PG8_WAIT_L(8); PG8_BAR; PG8_WAIT_L(0); PG8_MMA(0, 0, At, B0); PG8_BAR; PG8_SCHED;
            PG8_LDB(B1, 0, 1); PG8_STAGE(PG8_SB(0, 0), b2, voffB);
            PG8_BAR; PG8_WAIT_L(0); PG8_MMA(0, 1, At, B1); PG8_BAR;
            PG8_LDA(At, 0, 1); PG8_STAGE(PG8_SA(0, 0), a2, voffA);
            PG8_BAR; PG8_WAIT_L(0); PG8_MMA(1, 0, At, B0); PG8_BAR; PG8_SCHED;
            PG8_STAGE(PG8_SB(0, 1), b2 + hstep, voffB);
            PG8_WAIT_V(6); PG8_BAR; PG8_MMA(1, 1, At, B1); PG8_BAR;
            PG8_LDB(B0, 1, 0); PG8_SCHED; PG8_LDA(At, 1, 0); PG8_STAGE(PG8_SA(0, 1), a2 + hstep, voffA);
            PG8_WAIT_L(8); PG8_BAR; PG8_WAIT_L(0); PG8_MMA(0, 0, At, B0); PG8_BAR; PG8_SCHED;
            PG8_LDB(B1, 1, 1); PG8_STAGE(PG8_SB(1, 0), b3, voffB);
            PG8_BAR; PG8_WAIT_L(0); PG8_MMA(0, 1, At, B1); PG8_BAR;
            PG8_LDA(At, 1, 1); PG8_STAGE(PG8_SA(1, 0), a3, voffA);
            PG8_BAR; PG8_WAIT_L(0); PG8_MMA(1, 0, At, B0); PG8_BAR; PG8_SCHED;
            PG8_STAGE(PG8_SB(1, 1), b3 + hstep, voffB);
            PG8_WAIT_V(6); PG8_BAR; PG8_MMA(1, 1, At, B1); PG8_BAR;
            }
        }
        if constexpr (ALIGN_EPI) { if (wr == 0) PG8_BAR; }
        if constexpr (!Epi::AFTER_DRAIN) { E(acc, cur, wr, wc, fr, fq); S.done(cur); }
        if (!has_next) break;
#pragma unroll
        for (int a = 0; a < 2; ++a)
#pragma unroll
            for (int b = 0; b < 2; ++b)
#pragma unroll
                for (int m = 0; m < 4; ++m)
#pragma unroll
                    for (int n = 0; n < 2; ++n) acc[a][b][m][n] = (f32x4){0.f, 0.f, 0.f, 0.f};
        cur = nxt; cA = nA; cB = nB; ++ui;
        if constexpr (ALIGN_EPI) { if (wr == 1) PG8_BAR; }
    }
    PG8_WAIT_V(0);
    if constexpr (!ALIGN_EPI) { if (wr == 0) PG8_BAR; }
    PG8_BAR;
    if constexpr (Epi::AFTER_DRAIN) { E.fused(acc, cur, wr, wc, fr, fq, lds, wid, lane); S.done(cur); }
#undef PG8_SA
#undef PG8_SB
#undef PG8_STAGE
#undef PG8_LDA
#undef PG8_LDB
#undef PG8_MMA
#undef PG8_WAIT_V
#undef PG8_WAIT_L
#undef PG8_BAR
#undef PG8_SCHED
}
}


#define GAS __attribute__((address_space(1)))
#define LAS __attribute__((address_space(3)))
#define DEV __device__ __forceinline__
typedef unsigned short bf16;
typedef unsigned v4u __attribute__((ext_vector_type(4)));
typedef unsigned v2u __attribute__((ext_vector_type(2)));
typedef float f32x4 __attribute__((ext_vector_type(4)));
typedef float f32x2 __attribute__((ext_vector_type(2)));
typedef GAS unsigned gu32;
#define RLX_AGENT __ATOMIC_RELAXED, __HIP_MEMORY_SCOPE_AGENT
#define LDS_WAIT() asm volatile("s_waitcnt lgkmcnt(0)" ::: "memory")
#define VM_WAIT() asm volatile("s_waitcnt vmcnt(0)" ::: "memory")

constexpr int T = 16384, NSMP = 128, MR = T + NSMP, MP = 16640, DM = 1024;
constexpr int NIN = 5632, DFF = 2816, NGU = 5632;
constexpr int DEC_B = 32, DEC_T = 4;
constexpr int NCB = 1023;
constexpr float EPS = 1e-6f;
constexpr float LOG2E = 1.4426950408889634f;
#ifndef PROBE_REP
#define PROBE_REP 0
#endif

constexpr size_t O_YP = 0, O_YS = O_YP + (size_t)T * DM, O_PKC = O_YS + (size_t)NSMP * DM, O_PVC = O_PKC + (size_t)T * 128, O_PKS = O_PVC + (size_t)T * 128,
                 O_PVS = O_PKS + (size_t)T * 128, O_PKW = O_PVS + (size_t)T * 128, O_PVW = O_PKW + 512 * 128, O_PH = O_PVW + 512 * 128, O_SKC = O_PH + 4 * 128 * 128,
                 O_SVC = O_SKC + 128 * 128, O_SKS = O_SVC + 128 * 128, O_SVS = O_SKS + 128 * 128, O_SKW = O_SVS + 128 * 128, O_SVW = O_SKW + (size_t)32 * 512 * 128,
                 O_SH = O_SVW + (size_t)32 * 512 * 128, O_END = O_SH + (size_t)32 * 4 * 128 * 128;
static_assert(O_END == 31850496, "d_out size");

constexpr size_t MiB = 1u << 20;
constexpr size_t al(size_t x) { return (x + MiB - 1) / MiB * MiB; }
constexpr size_t WS_CTL = 0, CTL_ZERO_BYTES = MiB;
constexpr size_t WS_TBL = WS_CTL + MiB;
constexpr size_t WS_WIN = WS_TBL + MiB;
constexpr size_t WS_WGU = WS_WIN + al((size_t)NIN * DM * 2);
constexpr size_t WS_WD = WS_WGU + al((size_t)NGU * DM * 2);
constexpr size_t WS_WPA = WS_WD + al((size_t)DM * DFF * 2);
constexpr size_t WS_WPB = WS_WPA + MiB;
constexpr size_t WS_WO = WS_WPB + MiB;
constexpr size_t WS_W1K = WS_WO + 2 * MiB;
constexpr size_t WS_W1V = WS_W1K + MiB;
constexpr size_t WS_W2K = WS_W1V + MiB / 2, WS_W2V = WS_W2K + 65536;
constexpr size_t WS_W1PK = WS_W1K + MiB / 2, WS_W1PV = WS_TBL + MiB / 2;
constexpr size_t WS_XN = WS_W1V + MiB;
constexpr size_t WS_QA = WS_XN + al((size_t)MP * DM * 2);
constexpr size_t WS_KS = WS_QA + al((size_t)MP * 512 * 2);
constexpr size_t WS_VS = WS_KS + 4 * MiB, WS_KW = WS_VS + 4 * MiB, WS_VW = WS_KW + 4 * MiB;
constexpr size_t WS_CKP = WS_VW + 4 * MiB;
constexpr size_t WS_CVP = WS_CKP + 5 * MiB;
constexpr size_t WS_GA = WS_CVP + 5 * MiB;
constexpr size_t WS_HQ = WS_GA + 2 * MiB;
constexpr size_t WS_HF = WS_HQ + al((size_t)MP * 512 * 2);
constexpr size_t WS_HI = WS_HF + al((size_t)MP * 512 * 4);
constexpr size_t WS_HG = WS_HI + al((size_t)MP * 512 * 2);
constexpr size_t WS_SGA = WS_HG + al((size_t)MP * 512 * 2);
constexpr size_t WS_SGB = WS_SGA + al((size_t)MP * DM * 2);
constexpr size_t WS_ACK = WS_SGB + al((size_t)MP * DM * 2);
constexpr size_t WS_ACV = WS_ACK + 128 * MiB;
constexpr size_t WS_TK = WS_ACV + 128 * MiB;
constexpr size_t WS_TV = WS_TK + 33 * MiB;
constexpr size_t WS_KCS = WS_TV + 33 * MiB;
constexpr size_t WS_VCS = WS_KCS + 8 * MiB;
constexpr size_t WS_KCP = WS_VCS + 8 * MiB;
constexpr size_t WS_VCP = WS_KCP + MiB;
constexpr size_t WS_HL = WS_VCP + MiB;
constexpr size_t WS_HD = WS_HL + 64 * MiB;
constexpr size_t WS_HIN = WS_HD + MiB;
constexpr size_t WS_HQT = WS_HIN + 32 * MiB;
constexpr size_t WS_HO = WS_HQT + 32 * MiB;
constexpr size_t WS_OA = WS_HO + MiB;
constexpr size_t WS_OB = WS_OA + al((size_t)MP * 512 * 2);
constexpr size_t WS_PT = WS_OB + al((size_t)MP * 512 * 2);
constexpr size_t WS_MG = WS_PT + al((size_t)MP * DM * 4);
constexpr size_t WS_X1 = WS_MG + al((size_t)MP * DM * 2);
constexpr size_t WS_FF = WS_X1 + al((size_t)MP * DM * 4);
constexpr size_t WS_END = WS_FF + al((size_t)MP * DFF * 2);
constexpr int CTL_Q = 16384 + 512;
constexpr int CTL_PC = 98304;
constexpr size_t WS_XS = WS_TBL + 128 * 1024;
constexpr int CTL_HB = 16384;
constexpr int TB_LB = 0, TB_HBK = 512, TB_HBV = 640, TB_BIAS = 768  , TB_END = 768 + 8 * 129;

constexpr int RING_BYTES = 139264;
constexpr int LDSCTL_OFF = RING_BYTES;
constexpr int LDSBIAS_OFF = RING_BYTES + 64;
constexpr int LDS_BYTES = 147456;
static_assert(LDSBIAS_OFF + 8 * 129 * 4 <= LDS_BYTES, "LDS map");

__device__ __constant__ unsigned char T5_BUCKET[129] = {0, 1, 2, 3, 4, 5, 6, 7, 8, 9, 10, 11, 12, 13, 14, 15, 16, 16, 16, 17, 17, 18, 18, 18, 19, 19, 19, 20, 20, 20, 20, 21, 21, 21, 21, 22, 22, 22, 22, 22, 23, 23, 23, 23, 23, 23, 24, 24, 24, 24, 24, 24, 25, 25, 25, 25, 25, 25, 25, 26, 26, 26, 26, 26, 26, 26, 26, 27, 27, 27, 27, 27, 27, 27, 27, 27, 27, 28, 28, 28, 28, 28, 28, 28, 28, 28, 28, 29, 29, 29, 29, 29, 29, 29, 29, 29, 29, 29, 29, 30, 30, 30, 30, 30, 30, 30, 30, 30, 30, 30, 30, 30, 30, 31, 31, 31, 31, 31, 31, 31, 31, 31, 31, 31, 31, 31, 31, 31, 31};

DEV unsigned f2bf(float f) { unsigned u = __builtin_bit_cast(unsigned, f); return (u + 0x7fffu + ((u >> 16) & 1u)) >> 16; }
DEV unsigned pk2(float lo, float hi) { return f2bf(lo) | (f2bf(hi) << 16); }
DEV float bf2f(unsigned h) { return __builtin_bit_cast(float, h << 16); }
DEV float bflo(unsigned w) { return __builtin_bit_cast(float, w << 16); }
DEV float bfhi(unsigned w) { return __builtin_bit_cast(float, w & 0xffff0000u); }
DEV float wave_sum(float v) {
#pragma unroll
    for (int o = 1; o < 64; o <<= 1) v += __shfl_xor(v, o);
    return v;
}
DEV float wave_max(float v) {
#pragma unroll
    for (int o = 1; o < 64; o <<= 1) v = fmaxf(v, __shfl_xor(v, o));
    return v;
}
DEV float sigmoidf(float x) { return 1.0f / (1.0f + __expf(-x)); }
DEV float siluf(float x) { return x / (1.0f + __expf(-x)); }
DEV float gelu_tanh(float x) { const float u = 0.7978845608028654f * (x + 0.044715f * x * x * x); const float e = __expf(2.0f * u); const float th = 1.0f - 2.0f / (e + 1.0f); return 0.5f * x * (1.0f + th); }

typedef short ab8 __attribute__((ext_vector_type(8)));
typedef short s16x4 __attribute__((ext_vector_type(4)));
#define NEG_INF (-__builtin_inff())
DEV float dpp_xor1(float v) { return __builtin_bit_cast(float, __builtin_amdgcn_update_dpp(0, __builtin_bit_cast(int, v), 0xB1, 0xF, 0xF, true)); }
DEV float dpp_xor2(float v) { return __builtin_bit_cast(float, __builtin_amdgcn_update_dpp(0, __builtin_bit_cast(int, v), 0x4E, 0xF, 0xF, true)); }
DEV s16x4 vtr(const LAS unsigned char* p) { typedef short v4i16_t __attribute__((ext_vector_type(4))); return __builtin_bit_cast(s16x4, __builtin_amdgcn_ds_read_tr16_b64_v4i16((LAS v4i16_t*)p)); }
DEV unsigned cvtpk(float lo, float hi) { typedef float f2 __attribute__((ext_vector_type(2))); typedef __bf16 b2 __attribute__((ext_vector_type(2))); f2 v = {lo, hi}; b2 b = __builtin_convertvector(v, b2); return __builtin_bit_cast(unsigned, b); }
#define XB_TMO      128
#define XB_XCNT(j)  (256  + 64 * (j))
#define XB_XSUB(j)  (1280 + 64 * (j))
#define XB_XGEN(j)  (2304 + 64 * (j))
#define XB_TOP      3328
#define XB_TOPGEN   3392
#define XCD_BAR_WORDS 3456
#define XB_SPIN_CAP (1u << 18)
DEV unsigned xb_ld(unsigned* p)              { return __hip_atomic_load(p, __ATOMIC_RELAXED, __HIP_MEMORY_SCOPE_AGENT); }
DEV unsigned xb_add(unsigned* p, unsigned v) { return __hip_atomic_fetch_add(p, v, __ATOMIC_RELAXED, __HIP_MEMORY_SCOPE_AGENT); }
DEV unsigned xb_xcc_id() { return (unsigned)__builtin_amdgcn_s_getreg((3 << 11) | 20) & 0xFu; }
#define XB_SPIN(cond, bar) do { unsigned _sp = 0; while (cond) { __builtin_amdgcn_s_sleep(1); \
    if ((++_sp & 255u) == 0u) { if (xb_ld(&(bar)[XB_TMO])) break; if (_sp > XB_SPIN_CAP) { atomicAdd(&(bar)[XB_TMO], 1u); break; } } } } while (0)
struct XcdBarrier { unsigned* bar; unsigned x; volatile LAS unsigned* st; };
DEV XcdBarrier xcd_barrier_post(unsigned* bar, volatile LAS unsigned* st) {
    XcdBarrier b; b.bar = bar; b.x = xb_xcc_id(); b.st = st;
    if (threadIdx.x == 0) (void)xb_add(&bar[XB_XCNT(b.x)], 1u);
    return b;
}
DEV void xcd_barrier_complete(unsigned* bar, unsigned x, unsigned& nloc, unsigned& nx) {
    const unsigned G = gridDim.x * gridDim.y * gridDim.z;
    unsigned sum, cnt, mine, sp = 0u;
    for (;;) {
        sum = 0u; cnt = 0u; mine = 0u;
#pragma unroll
        for (unsigned j = 0; j < 16; ++j) { const unsigned c = xb_ld(&bar[XB_XCNT(j)]); sum += c; cnt += (c > 0u) ? 1u : 0u; mine = (j == x) ? c : mine; }
        if (sum == G) break;
        __builtin_amdgcn_s_sleep(1);
        if ((++sp & 255u) == 0u) { if (xb_ld(&bar[XB_TMO])) break; if (sp > XB_SPIN_CAP) { atomicAdd(&bar[XB_TMO], 1u); break; } }
    }
    nloc = mine > 0u ? mine : 1u; nx = cnt > 0u ? cnt : 1u;
}
DEV void xcd_barrier(const XcdBarrier& b) {
    asm volatile("s_waitcnt vmcnt(0)" ::: "memory");
    __syncthreads();
    if (threadIdx.x == 0) {
        unsigned* bar = b.bar;
        __builtin_amdgcn_s_waitcnt(0);
        unsigned nloc = b.st[0], nx = b.st[1];
        if (nloc == 0u) { xcd_barrier_complete(bar, b.x, nloc, nx); b.st[0] = nloc; b.st[1] = nx; }
        const unsigned old = xb_add(&bar[XB_XSUB(b.x)], 1u);
        const unsigned gen = old / nloc;
        if (old + 1u == (gen + 1u) * nloc) {
            __builtin_amdgcn_fence(__ATOMIC_RELEASE, "agent");
            asm volatile("s_waitcnt vmcnt(0)" ::: "memory");
            const unsigned og = xb_add(&bar[XB_TOP], 1u);
            const unsigned tg = og / nx;
            if (og + 1u == (tg + 1u) * nx) xb_add(&bar[XB_TOPGEN], 1u);
            else XB_SPIN(xb_ld(&bar[XB_TOPGEN]) == tg, bar);
            __builtin_amdgcn_fence(__ATOMIC_ACQUIRE, "agent");
            xb_add(&bar[XB_XGEN(b.x)], 1u);
            asm volatile("s_waitcnt vmcnt(0)" ::: "memory");
        } else {
            XB_SPIN(xb_ld(&bar[XB_XGEN(b.x)]) == gen, bar);
            __builtin_amdgcn_fence(__ATOMIC_ACQUIRE, "agent");
            asm volatile("s_waitcnt vmcnt(0)" ::: "memory");
        }
    }
    __syncthreads();
}

struct Args { const void* in[29]; float* out; unsigned char* ws; int ph_lo, ph_hi; };
struct Frame {
    const Args& A;
    LAS unsigned char* lds;
    int tid, lane, wave, vcu, G;
    float* out; unsigned char* ws;
};
template <class Tp> DEV Tp* wsp(const Frame& F, size_t off) { return (Tp*)(F.ws + off); }

DEV void tr_item(const float* src, int ldsrc, int sk0, int scol0, bf16* dst, int ldd, int drow0, int dk0, int nvalid, LAS float* scr, int lane) {
    { float t[32];
#pragma unroll
      for (int i = 0; i < 32; ++i) { const int kk = 2 * i + (lane >> 5), n = lane & 31; t[i] = (n < nvalid) ? src[(size_t)(sk0 + kk) * ldsrc + scol0 + n] : 0.f; }
#pragma unroll
      for (int i = 0; i < 32; ++i) { const int kk = 2 * i + (lane >> 5), n = lane & 31; scr[kk * 33 + n] = t[i]; } }
    LDS_WAIT(); asm volatile("" ::: "memory");
    const int c = lane & 7;
#pragma unroll
    for (int j = 0; j < 4; ++j) { const int n = (lane >> 3) + 8 * j; const LAS float* s = scr + (8 * c) * 33 + n;
        v4u o; o.x = pk2(s[0 * 33], s[1 * 33]); o.y = pk2(s[2 * 33], s[3 * 33]); o.z = pk2(s[4 * 33], s[5 * 33]); o.w = pk2(s[6 * 33], s[7 * 33]);
        *(v4u*)(dst + (size_t)(drow0 + n) * ldd + dk0 + 8 * c) = o; }
    LDS_WAIT(); asm volatile("" ::: "memory");
}
DEV void tr_item_frag(const float* src, int sk0, int scol0, bf16* dst, LAS float* scr, int lane) {
    { float t[32];
#pragma unroll
      for (int i = 0; i < 32; ++i) { const int kk = 2 * i + (lane >> 5), n = lane & 31; t[i] = src[(size_t)(sk0 + kk) * 128 + scol0 + n]; }
#pragma unroll
      for (int i = 0; i < 32; ++i) { const int kk = 2 * i + (lane >> 5), n = lane & 31; scr[kk * 33 + n] = t[i]; } }
    LDS_WAIT(); asm volatile("" ::: "memory");
    const int c = lane & 7, k0 = sk0 + 8 * c;
#pragma unroll
    for (int j = 0; j < 4; ++j) { const int n = (lane >> 3) + 8 * j, e = scol0 + n; const LAS float* s = scr + (8 * c) * 33 + n;
        v4u o; o.x = pk2(s[0 * 33], s[1 * 33]); o.y = pk2(s[2 * 33], s[3 * 33]); o.z = pk2(s[4 * 33], s[5 * 33]); o.w = pk2(s[6 * 33], s[7 * 33]);
        *(v4u*)(dst + (size_t)((e >> 4) * 64 + (k0 >> 5)) * 512 + ((k0 >> 3) & 3) * 128 + (e & 15) * 8) = o; }
    LDS_WAIT(); asm volatile("" ::: "memory");
}
DEV void rms_row_bf16(const float* xrow, const float* gain, bf16* orow, int lane) {
    const f32x4* xr = (const f32x4*)xrow + lane; const f32x4* gr = (const f32x4*)gain + lane;
    f32x4 v[4]; float s = 0.f;
#pragma unroll
    for (int j = 0; j < 4; ++j) { v[j] = xr[64 * j]; s += (v[j].x * v[j].x + v[j].y * v[j].y) + (v[j].z * v[j].z + v[j].w * v[j].w); }
    const float r = 1.0f / sqrtf(wave_sum(s) * (1.f / DM) + EPS);
    v2u* o8 = (v2u*)orow + lane;
#pragma unroll
    for (int j = 0; j < 4; ++j) { const f32x4 g = gr[64 * j]; v2u w; w.x = pk2(v[j].x * r * g.x, v[j].y * r * g.y); w.y = pk2(v[j].z * r * g.z, v[j].w * r * g.w); o8[64 * j] = w; }
}
DEV void rms_row_f32(const float* xrow, const float* gain, float* orow, int lane) {
    const f32x4* xr = (const f32x4*)xrow + lane; const f32x4* gr = (const f32x4*)gain + lane;
    f32x4 v[4]; float s = 0.f;
#pragma unroll
    for (int j = 0; j < 4; ++j) { v[j] = xr[64 * j]; s += (v[j].x * v[j].x + v[j].y * v[j].y) + (v[j].z * v[j].z + v[j].w * v[j].w); }
    const float r = 1.0f / sqrtf(wave_sum(s) * (1.f / DM) + EPS);
    f32x4* o = (f32x4*)orow + lane;
#pragma unroll
    for (int j = 0; j < 4; ++j) { const f32x4 g = gr[64 * j]; o[64 * j] = v[j] * r * g; }
}

template <bool OUTF32, class SrcFn, class DstFn>
DEV void rms_rows(int m0, int mstep, int mend, SrcFn src, DstFn dst, const float* gain, int lane) {
    f32x4 g[4];
#pragma unroll
    for (int j = 0; j < 4; ++j) g[j] = ((const f32x4*)gain)[lane + 64 * j];
    for (int mb = m0; mb < mend; mb += 4 * mstep) {
        f32x4 v[4][4];
#pragma unroll
        for (int i = 0; i < 4; ++i) { const int m = mb + i * mstep; if (m < mend) { const f32x4* xr = (const f32x4*)src(m) + lane;
#pragma unroll
            for (int j = 0; j < 4; ++j) v[i][j] = xr[64 * j]; } }
#pragma unroll
        for (int i = 0; i < 4; ++i) { const int m = mb + i * mstep; if (m < mend) {
            float s = 0.f;
#pragma unroll
            for (int j = 0; j < 4; ++j) s += (v[i][j].x * v[i][j].x + v[i][j].y * v[i][j].y) + (v[i][j].z * v[i][j].z + v[i][j].w * v[i][j].w);
            const float r = 1.0f / sqrtf(wave_sum(s) * (1.f / DM) + EPS);
            if (OUTF32) { f32x4* o = (f32x4*)dst(m) + lane;
#pragma unroll
                for (int j = 0; j < 4; ++j) o[64 * j] = v[i][j] * r * g[j]; }
            else { v2u* o8 = (v2u*)dst(m) + lane;
#pragma unroll
                for (int j = 0; j < 4; ++j) { v2u w; w.x = pk2(v[i][j].x * r * g[j].x, v[i][j].y * r * g[j].y); w.y = pk2(v[i][j].z * r * g[j].z, v[i][j].w * r * g[j].w); o8[64 * j] = w; } } } }
    }
}
constexpr int I_IN = 16 * 176, I_GU = 16 * 176, I_D = 44 * 32, I_PA = 8 * 32, I_O = 16 * 32, I_W1 = 2 * 16 * 4;
constexpr int I_W1P = 32 * 4, NITEMS = I_IN + I_GU + I_D + 2 * I_PA + I_O + 2 * I_W1 + 8 + 2 * I_W1P;
constexpr int DEF_I0 = 2 * I_W1P + I_IN, DEF_I1 = DEF_I0 + I_GU + I_D + 2 * I_PA + I_O;
constexpr int DEF_NTR = DEF_I1 - DEF_I0, DEF_NWIN = 2 * 32 * 64, DEF_N = DEF_NTR + DEF_NWIN;
DEV void tr_dispatch(Frame& F, int it, LAS float* scr, int lane) {
    bf16* WIN = wsp<bf16>(F, WS_WIN); bf16* WGU = wsp<bf16>(F, WS_WGU); bf16* WD = wsp<bf16>(F, WS_WD);
    bf16* WPA = wsp<bf16>(F, WS_WPA); bf16* WPB = wsp<bf16>(F, WS_WPB); bf16* WO = wsp<bf16>(F, WS_WO);
    bf16* W1K = wsp<bf16>(F, WS_W1K); bf16* W1V = wsp<bf16>(F, WS_W1V);
        int r = it;
        if (r < 2 * I_W1P) { const int ty = r / I_W1P, rr = r % I_W1P; tr_item_frag(ty ? ((const float*)F.A.in[16]) : ((const float*)F.A.in[13]), 64 * (rr >> 2), 32 * (rr & 3), wsp<bf16>(F, ty ? WS_W1PV : WS_W1PK), scr, lane); return; }
        r -= 2 * I_W1P;
        if (r < I_IN) { const int kb = r / 176, nb = r % 176, n0 = 32 * nb;
            int sc, nv = 32;
            if (n0 < 1280) sc = n0; else if (n0 < 5376) sc = n0 + 24; else if (n0 < 5400) { sc = n0 - 5376 + 1280; nv = 5400 - n0 < 32 ? 5400 - n0 : 32; } else { sc = 0; nv = 0; }
            tr_item(((const float*)F.A.in[11]), 5400, 64 * kb, sc, WIN, DM, n0, 64 * kb, nv, scr, lane); return; }
        r -= I_IN;
        if (r < I_GU) { const int kb = r / 176, nb = r % 176, n0 = 32 * nb, p = n0 >> 8, j = n0 & 255;
            const float* src = (j < 128) ? ((const float*)F.A.in[25]) : ((const float*)F.A.in[26]); const int sc = 128 * p + (j & 127);
            tr_item(src, DFF, 64 * kb, sc, WGU, DM, n0, 64 * kb, 32, scr, lane); return; }
        r -= I_GU;
        if (r < I_D) { const int kb = r / 32, nb = r % 32; tr_item(((const float*)F.A.in[27]), DM, 64 * kb, 32 * nb, WD, DFF, 32 * nb, 64 * kb, 32, scr, lane); return; }
        r -= I_D;
        if (r < I_PA) { const int kb = r / 32, nb = r % 32; tr_item(((const float*)F.A.in[21]), DM, 64 * kb, 32 * nb, WPA, 512, 32 * nb, 64 * kb, 32, scr, lane); return; }
        r -= I_PA;
        if (r < I_PA) { const int kb = r / 32, nb = r % 32; tr_item(((const float*)F.A.in[22]), DM, 64 * kb, 32 * nb, WPB, 512, 32 * nb, 64 * kb, 32, scr, lane); return; }
        r -= I_PA;
        if (r < I_O) { const int kb = r / 32, nb = r % 32; tr_item(((const float*)F.A.in[23]), DM, 64 * kb, 32 * nb, WO, DM, 32 * nb, 64 * kb, 32, scr, lane); return; }
        r -= I_O;
        if (r >= 2 * I_W1) { r -= 2 * I_W1; const int ty = r >> 2, kb = (r >> 1) & 1, nb = r & 1;
            tr_item(ty ? ((const float*)F.A.in[17]) : ((const float*)F.A.in[14]), 64, 64 * kb, 32 * nb, wsp<bf16>(F, ty ? WS_W2V : WS_W2K), 128, 32 * nb, 64 * kb, 32, scr, lane); return; }
        { const int ty = r / I_W1; r -= ty * I_W1;
          const int half = r / 64, rr = r % 64, kb = rr / 4, nb = rr % 4;
          tr_item(ty ? ((const float*)F.A.in[16]) : ((const float*)F.A.in[13]), 128, half * 1024 + 64 * kb, 32 * nb, ty ? W1V : W1K, DM, half * 128 + 32 * nb, 64 * kb, 32, scr, lane); }
}
DEV void win_copy_item(Frame& F, int it, int lane) {
    const int ty = it >> 11, b = (it >> 6) & 31, pc = it & 63;
    const f32x4* src = (const f32x4*)((ty ? ((const float*)F.A.in[7]) : ((const float*)F.A.in[6])) + (size_t)(b * 512 + 4) * 128) + pc * 256 + lane;
    f32x4* dst = (f32x4*)(F.out + (ty ? O_SVW : O_SKW) + (size_t)(b * 512) * 128) + pc * 256 + lane;
    f32x4 t[4];
#pragma unroll
    for (int j = 0; j < 4; ++j) if (pc * 256 + lane + 64 * j < 16256) t[j] = src[64 * j];
#pragma unroll
    for (int j = 0; j < 4; ++j) if (pc * 256 + lane + 64 * j < 16256) dst[64 * j] = t[j];
}
DEV void p0_prologue(Frame& F, bool first) {
    LAS float* scr = (LAS float*)(F.lds + F.wave * 16384);
    const int gw = F.vcu * 8 + F.wave, NGW = F.G * 8, lane = F.lane;
    bf16* WIN = wsp<bf16>(F, WS_WIN); bf16* WGU = wsp<bf16>(F, WS_WGU); bf16* WD = wsp<bf16>(F, WS_WD);
    bf16* WPA = wsp<bf16>(F, WS_WPA); bf16* WPB = wsp<bf16>(F, WS_WPB); bf16* WO = wsp<bf16>(F, WS_WO);
    bf16* W1K = wsp<bf16>(F, WS_W1K); bf16* W1V = wsp<bf16>(F, WS_W1V);
    for (int it = gw; it < NITEMS; it += NGW) { if (it >= DEF_I0 && it < DEF_I1) continue; tr_dispatch(F, it, scr, lane); }
    bf16* XN = wsp<bf16>(F, WS_XN);
    { const float* xp = (const float*)F.A.in[0]; const float* xs = (const float*)F.A.in[1];
      rms_rows<false>(gw, NGW, MR, [&](int m) { return m < T ? xp + (size_t)m * DM : xs + (size_t)(m - T) * DM; }, [&](int m) { return XN + (size_t)m * DM; }, ((const float*)F.A.in[10]), lane);
      for (int m = MR + gw; m < MP; m += NGW) { v4u z = {0u, 0u, 0u, 0u}; v4u* o = (v4u*)(XN + (size_t)m * DM); o[lane] = z; o[lane + 64] = z; } }
    if (first && F.vcu >= F.G - 17 && F.vcu < F.G - 1) {
        const int jb = F.vcu - (F.G - 17), tid = F.tid, e = tid & 127, ty = (tid >> 7) & 1, half = tid >> 8;
        const float* pe = ty ? ((const float*)F.A.in[15]) : ((const float*)F.A.in[12]); const float* w1 = ty ? ((const float*)F.A.in[16]) : ((const float*)F.A.in[13]);
        float s0 = 0.f, s1 = 0.f;
#pragma unroll 8
        for (int k = jb * 128 + half * 64; k < jb * 128 + half * 64 + 64; k += 2) { s0 += pe[k] * w1[(size_t)k * 128 + e]; s1 += pe[k + 1] * w1[(size_t)(k + 1) * 128 + e]; }
        atomicAdd(wsp<float>(F, WS_CTL) + CTL_HB + ty * 128 + e, s0 + s1);
    }
    if (F.vcu == F.G - 1) {
        float* TB = wsp<float>(F, WS_TBL); const int tid = F.tid;
        { const float l0 = ((const float*)F.A.in[19])[tid], l1 = ((const float*)F.A.in[19])[512 + tid]; TB[TB_LB + tid] = 1.0f / (1.0f + __expf(l1 - l0)); }
        for (int i = tid; i < 8 * 129; i += 512) { const int h = i / 129, n = i % 129; TB[TB_BIAS + i] = ((const float*)F.A.in[18])[(int)T5_BUCKET[n] * 8 + h]; }
    }
}

DEV void static_unit(int wgid0, int nM, int nN, int& pm, int& pn) {
    const int nwg = nM * nN; int wgid = wgid0;
    { const int q = nwg / pg8::NXCD, r = nwg % pg8::NXCD, xcd = wgid % pg8::NXCD, off = wgid / pg8::NXCD; wgid = (xcd < r ? xcd * (q + 1) : r * (q + 1) + (xcd - r) * q) + off; }
    const int nig = pg8::WGM * nN, gid = wgid / nig, fm = gid * pg8::WGM, gsz = (nM - fm) < pg8::WGM ? (nM - fm) : pg8::WGM;
    pm = fm + ((wgid % nig) % gsz); pn = (wgid % nig) / gsz;
}
struct SchedOne {
    const char* A; const char* B; int nM, nN, K, G, c;
    DEV bool next(int i, pg8::Unit& u) const { const long L = (long)i * G + c; if (L >= (long)nM * nN) return false; int pm = 0, pn = 0; static_unit((int)L, nM, nN, pm, pn); u.pm = pm; u.pn = pn; u.gi = 0; return true; }
    DEV void ptrs(const pg8::Unit& u, const char*& a, const char*& b) const { a = A + (size_t)u.pm * 512 * K; b = B + (size_t)u.pn * 512 * K; }
    DEV void a_ready(const pg8::Unit&) const {}
    DEV void done(const pg8::Unit&) const {}
};
constexpr int P1_NM = MP / 256, P1_NN = NIN / 256, P1_U0 = P1_NM * P1_NN;
struct SchedP1 {
    const char *A0, *B0, *A1, *B1, *A2, *B2; int G, c;
    DEV bool next(int i, pg8::Unit& u) const { const long L = (long)i * G + c; if (L >= P1_U0 + 512) return false;
        int pm = 0, pn = 0; static_unit(L < P1_U0 ? (int)L : 0, P1_NM, P1_NN, pm, pn);
        const int l = (int)L - P1_U0; const bool cmp = L >= P1_U0;
        u.pm = cmp ? (l & 255) : pm; u.pn = cmp ? 0 : pn; u.gi = cmp ? 1 + (l >> 8) : 0; return true; }
    DEV void ptrs(const pg8::Unit& u, const char*& a, const char*& b) const {
        if (u.gi == 0) { a = A0 + (size_t)u.pm * 524288; b = B0 + (size_t)u.pn * 524288; } else if (u.gi == 1) { a = A1 + (size_t)u.pm * 524288; b = B1; } else { a = A2 + (size_t)u.pm * 524288; b = B2; } }
    DEV void a_ready(const pg8::Unit&) const {}
    DEV void done(const pg8::Unit&) const {}
};

DEV void st_bf16x8(bf16* p, const f32x4 a, const f32x4 b) { v4u w; w.x = pg8::cvt_pk_bf16(a[0], a[1]); w.y = pg8::cvt_pk_bf16(a[2], a[3]); w.z = pg8::cvt_pk_bf16(b[0], b[1]); w.w = pg8::cvt_pk_bf16(b[2], b[3]); *(v4u*)p = w; }
DEV f32x4 map_silu(f32x4 v) { return (f32x4){siluf(v[0]), siluf(v[1]), siluf(v[2]), siluf(v[3])}; }
DEV f32x4 map_sigm(f32x4 v) { return (f32x4){sigmoidf(v[0]), sigmoidf(v[1]), sigmoidf(v[2]), sigmoidf(v[3])}; }

#define EPI_ROWS(...) _Pragma("unroll") for (int ai = 0; ai < 2; ++ai) _Pragma("unroll") for (int m = 0; m < 4; ++m) { const int r = u.pm * 256 + ai * 128 + wr * 64 + m * 16 + fr; __VA_ARGS__ }
constexpr float QSCALE_ = 0.125f * 1.4426950408889634f;
struct EpiP1 {
    static constexpr bool PERM = true, AFTER_DRAIN = false;
    float* out; bf16 *QA, *KS, *VS, *KW, *VW, *CKP, *CVP, *HQ, *HI, *HG, *SGA, *SGB, *TK, *TV; float *HF, *GA;
    DEV void operator()(const f32x4 (&acc)[2][2][4][2], const pg8::Unit& u, int wr, int wc, int fr_, int fq_) const { int fr = fr_, fq = fq_; asm volatile("" : "+v"(fr), "+v"(fq));
        const int cw = wc * 32 + 8 * fq;
        if (u.gi != 0) { bf16* Tb = (u.gi == 1) ? TK : TV;
            EPI_ROWS({ _Pragma("unroll") for (int bj = 0; bj < 2; ++bj) st_bf16x8(Tb + (size_t)r * 256 + bj * 128 + cw, acc[ai][bj][m][0], acc[ai][bj][m][1]); })
            return; }
        const int pn = u.pn;
        if (pn < 2) { EPI_ROWS({ if (r < MR) { _Pragma("unroll") for (int bj = 0; bj < 2; ++bj) st_bf16x8(QA + (size_t)r * 512 + pn * 256 + bj * 128 + cw, acc[ai][bj][m][0] * QSCALE_, acc[ai][bj][m][1] * QSCALE_); } }) }
        else if (pn == 2) {
            EPI_ROWS({ if (r < MR) { _Pragma("unroll") for (int bj = 0; bj < 2; ++bj) { const f32x4 a = acc[ai][bj][m][0], b = acc[ai][bj][m][1];
                float* o = (r < T) ? out + (bj ? O_PVC : O_PKC) + (size_t)r * 128 + cw : out + (bj ? O_SVC : O_SKC) + (size_t)(r - T) * 128 + cw;
                *(f32x4*)o = a; *(f32x4*)(o + 4) = b;
                if (r < T) { const int kv = cw >> 6, d = cw & 63; st_bf16x8((bj ? CVP : CKP) + ((size_t)(kv * 1024 + (r >> 4)) * 1024 + (r & 15) * 64 + d), a, b); } } } }) }
        else if (pn == 3) {
            EPI_ROWS({ if (r < MR) { _Pragma("unroll") for (int bj = 0; bj < 2; ++bj) { const f32x4 a = acc[ai][bj][m][0], b = acc[ai][bj][m][1];
                float* o = (r < T) ? out + (bj ? O_PVS : O_PKS) + (size_t)r * 128 + cw : out + (bj ? O_SVS : O_SKS) + (size_t)(r - T) * 128 + cw;
                *(f32x4*)o = a; *(f32x4*)(o + 4) = b;
                if (r < T) st_bf16x8((bj ? VS : KS) + (size_t)r * 128 + cw, a, b); } } }) }
        else if (pn == 4) {
            EPI_ROWS({ if (r < MR) { _Pragma("unroll") for (int bj = 0; bj < 2; ++bj) { const f32x4 a = acc[ai][bj][m][0], b = acc[ai][bj][m][1];
                if (r < T) { st_bf16x8((bj ? VW : KW) + (size_t)r * 128 + cw, a, b);
                    if (r >= T - 512) { float* o = out + (bj ? O_PVW : O_PKW) + (size_t)(r - (T - 512)) * 128 + cw; *(f32x4*)o = a; *(f32x4*)(o + 4) = b; } }
                else { const int rs = r - T; float* o = out + (bj ? O_SVW : O_SKW) + (size_t)((rs >> 2) * 512 + 508 + (rs & 3)) * 128 + cw; *(f32x4*)o = a; *(f32x4*)(o + 4) = b; } } } }) }
        else if (pn < 7) { EPI_ROWS({ if (r < MR) { _Pragma("unroll") for (int bj = 0; bj < 2; ++bj) st_bf16x8(HQ + (size_t)r * 512 + (pn - 5) * 256 + bj * 128 + cw, map_silu(acc[ai][bj][m][0]), map_silu(acc[ai][bj][m][1])); } }) }
        else if (pn < 9) { EPI_ROWS({ if (r < MR) { _Pragma("unroll") for (int bj = 0; bj < 2; ++bj) { float* o = HF + (size_t)r * 512 + (pn - 7) * 256 + bj * 128 + cw; *(f32x4*)o = acc[ai][bj][m][0]; *(f32x4*)(o + 4) = acc[ai][bj][m][1]; } } }) }
        else if (pn < 11) { EPI_ROWS({ if (r < MR) { _Pragma("unroll") for (int bj = 0; bj < 2; ++bj) st_bf16x8(HI + (size_t)r * 512 + (pn - 9) * 256 + bj * 128 + cw, acc[ai][bj][m][0], acc[ai][bj][m][1]); } }) }
        else if (pn < 13) { EPI_ROWS({ if (r < MR) { _Pragma("unroll") for (int bj = 0; bj < 2; ++bj) st_bf16x8(HG + (size_t)r * 512 + (pn - 11) * 256 + bj * 128 + cw, map_silu(acc[ai][bj][m][0]), map_silu(acc[ai][bj][m][1])); } }) }
        else if (pn < 17) { EPI_ROWS({ if (r < MR) { _Pragma("unroll") for (int bj = 0; bj < 2; ++bj) st_bf16x8(SGA + (size_t)r * 1024 + (pn - 13) * 256 + bj * 128 + cw, map_sigm(acc[ai][bj][m][0]), map_sigm(acc[ai][bj][m][1])); } }) }
        else if (pn < 21) { EPI_ROWS({ if (r < MR) { _Pragma("unroll") for (int bj = 0; bj < 2; ++bj) st_bf16x8(SGB + (size_t)r * 1024 + (pn - 17) * 256 + bj * 128 + cw, map_sigm(acc[ai][bj][m][0]), map_sigm(acc[ai][bj][m][1])); } }) }
        else { if (cw < 24) { EPI_ROWS({ if (r < MR) { float* o = GA + (size_t)r * 24 + cw; *(f32x4*)o = map_sigm(acc[ai][0][m][0]); *(f32x4*)(o + 4) = map_sigm(acc[ai][0][m][1]); } }) } }
    }
};
#define EPI_ALL(...) _Pragma("unroll") for (int ai = 0; ai < 2; ++ai) _Pragma("unroll") for (int m = 0; m < 4; ++m) { const int r = u.pm * 256 + ai * 128 + wr * 64 + m * 16 + fr; if (r < MR) { \
    _Pragma("unroll") for (int bj = 0; bj < 2; ++bj) _Pragma("unroll") for (int n = 0; n < 2; ++n) { const int c = u.pn * 256 + bj * 128 + wc * 32 + 16 * n + 4 * fq; const f32x4 v = acc[ai][bj][m][n]; __VA_ARGS__ } } }
DEV f32x4 ld_bf16x4(const bf16* p) { const v2u w = *(const v2u*)p; return (f32x4){bflo(w.x), bfhi(w.x), bflo(w.y), bfhi(w.y)}; }
DEV void st_bf16x4(bf16* p, const f32x4 v) { v2u w; w.x = pg8::cvt_pk_bf16(v[0], v[1]); w.y = pg8::cvt_pk_bf16(v[2], v[3]); *(v2u*)p = w; }
struct EpiProjA {
    static constexpr bool PERM = false, AFTER_DRAIN = false; const bf16* SG; float* PT;
    DEV void apply(int r, int c, const f32x4 v) const { *(f32x4*)(PT + (size_t)r * DM + c) = v * ld_bf16x4(SG + (size_t)r * DM + c); }
    DEV void operator()(const f32x4 (&acc)[2][2][4][2], const pg8::Unit& u, int wr, int wc, int fr_, int fq_) const { int fr = fr_, fq = fq_; asm volatile("" : "+v"(fr), "+v"(fq));
        EPI_ALL({ apply(r, c, v); }) }
};
struct EpiProjB {
    static constexpr bool PERM = false, AFTER_DRAIN = false; const bf16* SG; const float* PT; bf16* MG;
    DEV void apply(int r, int c, const f32x4 v) const { st_bf16x4(MG + (size_t)r * DM + c, *(const f32x4*)(PT + (size_t)r * DM + c) + v * ld_bf16x4(SG + (size_t)r * DM + c)); }
    DEV void operator()(const f32x4 (&acc)[2][2][4][2], const pg8::Unit& u, int wr, int wc, int fr_, int fq_) const { int fr = fr_, fq = fq_; asm volatile("" : "+v"(fr), "+v"(fq));
        EPI_ALL({ apply(r, c, v); }) }
};
struct EpiResid {
    static constexpr bool PERM = false, AFTER_DRAIN = false; const float* xp; const float* xs; float* O;
    DEV void apply(int r, int c, const f32x4 v) const { const float* b = (xs && r >= T) ? xs + (size_t)(r - T) * DM + c : xp + (size_t)r * DM + c; *(f32x4*)(O + (size_t)r * DM + c) = *(const f32x4*)b + v; }
    DEV void operator()(const f32x4 (&acc)[2][2][4][2], const pg8::Unit& u, int wr, int wc, int fr_, int fq_) const { int fr = fr_, fq = fq_; asm volatile("" : "+v"(fr), "+v"(fq));
        EPI_ALL({ apply(r, c, v); }) }
};
struct EpiFinal {
    static constexpr bool PERM = false, AFTER_DRAIN = true; const float* base; float* out; const float* gain; float* xs; unsigned* cnt;
    DEV void operator()(const f32x4 (&)[2][2][4][2], const pg8::Unit&, int, int, int, int) const {}
    DEV void fused(f32x4 (&acc)[2][2][4][2], const pg8::Unit& u, int wr, int wc, int fr_, int fq_, LAS unsigned char* lds, int wid, int lane_) const {
        int fr = fr_, fq = fq_, lane = lane_; asm volatile("" : "+v"(fr), "+v"(fq), "+v"(lane));
        LAS float* P = (LAS float*)lds;
        LAS float* S = (LAS float*)(lds + 8192);
        const int col0 = u.pn * 256 + wc * 32 + 4 * fq;
#pragma unroll
        for (int ai = 0; ai < 2; ++ai)
#pragma unroll
            for (int m = 0; m < 4; ++m) { const int rl = ai * 128 + wr * 64 + m * 16 + fr; const size_t off = (size_t)(u.pm * 256 + rl) * DM + col0; float ss = 0.f;
#pragma unroll
                for (int bj = 0; bj < 2; ++bj)
#pragma unroll
                    for (int n = 0; n < 2; ++n) { const f32x4 x = *(const f32x4*)(base + off + bj * 128 + n * 16) + acc[ai][bj][m][n]; acc[ai][bj][m][n] = x; ss += (x[0] * x[0] + x[1] * x[1]) + (x[2] * x[2] + x[3] * x[3]); }
                ss += __shfl_xor(ss, 16); ss += __shfl_xor(ss, 32);
                if (fq == 0) P[rl * 4 + wc] = ss; }
        asm volatile("s_waitcnt lgkmcnt(0)" ::: "memory"); __builtin_amdgcn_s_barrier(); asm volatile("" ::: "memory");
        const int row = wid * 32 + (lane & 31);
        if (lane < 32) { const float tot = (P[row * 4 + 0] + P[row * 4 + 1]) + (P[row * 4 + 2] + P[row * 4 + 3]);
            __hip_atomic_store(xs + ((size_t)(u.pm * 256 + row) * 4 + u.pn), tot, __ATOMIC_RELAXED, __HIP_MEMORY_SCOPE_AGENT); }
        asm volatile("s_waitcnt vmcnt(0)" ::: "memory");
        if (lane == 0) (void)xb_add(cnt + 64 * u.pm, 1u);
        if (wid == 0) { unsigned sp = 0u;
            while ((unsigned)__builtin_amdgcn_readfirstlane((int)xb_ld(cnt + 64 * u.pm)) < 32u) { __builtin_amdgcn_s_sleep(2); if (++sp > (1u << 22)) break; }
            __builtin_amdgcn_fence(__ATOMIC_ACQUIRE, "agent"); }
        asm volatile("s_waitcnt vmcnt(0) lgkmcnt(0)" ::: "memory"); __builtin_amdgcn_s_barrier(); asm volatile("" ::: "memory");
        if (lane < 32) { const float* sl = xs + (size_t)(u.pm * 256 + row) * 4; float tot = 0.f;
#pragma unroll
            for (int t = 0; t < 4; ++t) tot += __hip_atomic_load(sl + t, __ATOMIC_RELAXED, __HIP_MEMORY_SCOPE_AGENT);
            S[row] = 1.0f / sqrtf(tot * (1.f / DM) + EPS); }
        asm volatile("s_waitcnt lgkmcnt(0)" ::: "memory"); __builtin_amdgcn_s_barrier(); asm volatile("" ::: "memory");
        f32x4 g[2][2];
#pragma unroll
        for (int bj = 0; bj < 2; ++bj)
#pragma unroll
            for (int n = 0; n < 2; ++n) g[bj][n] = *(const f32x4*)(gain + col0 + bj * 128 + n * 16);
#pragma unroll
        for (int ai = 0; ai < 2; ++ai)
#pragma unroll
            for (int m = 0; m < 4; ++m) { const int rl = ai * 128 + wr * 64 + m * 16 + fr; const float rs = S[rl]; const size_t off = (size_t)(u.pm * 256 + rl) * DM + col0;
#pragma unroll
                for (int bj = 0; bj < 2; ++bj)
#pragma unroll
                    for (int n = 0; n < 2; ++n) *(f32x4*)(out + off + bj * 128 + n * 16) = acc[ai][bj][m][n] * rs * g[bj][n]; }
    }
};
template <int K, class Epi> DEV void small_gemm(Frame& F, const bf16* A, const bf16* Bt, const Epi& E) {
    int lane = F.lane; asm volatile("" : "+v"(lane));
    typedef short ab8_ __attribute__((ext_vector_type(8)));
    constexpr int KW = K / 8; static_assert(KW % 32 == 0, "small_gemm K split");
    const int n = lane & 15, q4 = lane >> 4, w = F.wave, tid = F.tid;
    LAS f32x4* part = (LAS f32x4*)F.lds;
    for (int it = F.vcu; it < 256; it += F.G) { const int ct = it >> 2, rg = it & 3;
        const bf16* ap = A + (size_t)(T + 32 * rg + n) * K + w * KW + 8 * q4; const bf16* bp = Bt + (size_t)(16 * ct + n) * K + w * KW + 8 * q4;
        f32x4 acc0 = {0.f, 0.f, 0.f, 0.f}, acc1 = {0.f, 0.f, 0.f, 0.f};
#pragma unroll
        for (int k0 = 0; k0 < KW; k0 += 32) { const ab8_ b = *(const ab8_*)(bp + k0), a0 = *(const ab8_*)(ap + k0), a1 = *(const ab8_*)(ap + (size_t)16 * K + k0);
            acc0 = __builtin_amdgcn_mfma_f32_16x16x32_bf16(b, a0, acc0, 0, 0, 0); acc1 = __builtin_amdgcn_mfma_f32_16x16x32_bf16(b, a1, acc1, 0, 0, 0); }
        part[(w * 2 + 0) * 64 + lane] = acc0; part[(w * 2 + 1) * 64 + lane] = acc1;
        __syncthreads();
        if (tid < 128) { const int mt = tid >> 6; f32x4 sum = part[mt * 64 + lane];
#pragma unroll
            for (int ww = 1; ww < 8; ++ww) sum += part[(ww * 2 + mt) * 64 + lane];
            E.apply(T + 32 * rg + 16 * mt + n, 16 * ct + 4 * q4, sum); }
        __syncthreads();
    }
}
struct EpiFfUp {
    static constexpr bool PERM = true, AFTER_DRAIN = false; bf16* FF;
    DEV void operator()(const f32x4 (&acc)[2][2][4][2], const pg8::Unit& u, int wr, int wc, int fr_, int fq_) const { int fr = fr_, fq = fq_; asm volatile("" : "+v"(fr), "+v"(fq));
        const int f0 = u.pn * 128 + wc * 32 + 8 * fq;
        EPI_ROWS({ if (r < MR) st_bf16x8(FF + (size_t)r * DFF + f0, map_silu(acc[ai][0][m][0]) * acc[ai][1][m][0], map_silu(acc[ai][0][m][1]) * acc[ai][1][m][1]); }) }
};

constexpr int CG_BROW = 144, CG_BUF = 256 * CG_BROW;
DEV void cmp_gemm_unit(Frame& F, int ty, int pm) {
    int lane = F.lane; asm volatile("" : "+v"(lane));
    const int n = lane & 15, q4 = lane >> 4, w = F.wave, tid = F.tid;
    const float* pool = ty ? ((const float*)F.A.in[3]) : ((const float*)F.A.in[2]); const int* ptab = (const int*)F.A.in[9];
    const float* arow[2];
#pragma unroll
    for (int mt = 0; mt < 2; ++mt) { const int r = pm * 256 + 32 * w + 16 * mt + n, b = r >> 11, c = (r >> 1) & 1023, kv = r & 1;
        arow[mt] = pool + (size_t)ptab[b * 128 + (c >> 3)] * 16384 + (size_t)((c & 7) * 16) * 128 + kv * 64 + 8 * q4; }
    const bf16* bsrc = wsp<bf16>(F, ty ? WS_W1V : WS_W1K) + (size_t)(tid >> 1) * 1024 + 32 * (tid & 1);
    LAS unsigned char* bdst = F.lds + (tid >> 1) * CG_BROW + 64 * (tid & 1);
    f32x4 acc[2][16];
#pragma unroll
    for (int mt = 0; mt < 2; ++mt)
#pragma unroll
        for (int nt = 0; nt < 16; ++nt) acc[mt][nt] = (f32x4){0.f, 0.f, 0.f, 0.f};
    f32x4 ar[2][2][2]; v4u br[4];
#define CG_LOAD_A(sl) do { _Pragma("unroll") for (int mt = 0; mt < 2; ++mt) _Pragma("unroll") for (int ks = 0; ks < 2; ++ks) { const float* p_ = arow[mt] + (sl) * 128 + 32 * ks; ar[mt][ks][0] = *(const f32x4*)p_; ar[mt][ks][1] = *(const f32x4*)(p_ + 4); } } while (0)
#define CG_LOAD_B(sl) do { _Pragma("unroll") for (int j = 0; j < 4; ++j) br[j] = *(const v4u*)(bsrc + 64 * (sl) + 8 * j); } while (0)
#define CG_STORE_B(buf) do { _Pragma("unroll") for (int j = 0; j < 4; ++j) *(LAS v4u*)(bdst + (buf) * CG_BUF + 16 * j) = br[j]; } while (0)
    CG_LOAD_A(0); CG_LOAD_B(0); CG_STORE_B(0);
    __syncthreads();
#pragma unroll 1
    for (int sl = 0; sl < 16; ++sl) {
        ab8 af[2][2];
#pragma unroll
        for (int mt = 0; mt < 2; ++mt)
#pragma unroll
            for (int ks = 0; ks < 2; ++ks) { v4u wv; wv.x = pg8::cvt_pk_bf16(ar[mt][ks][0][0], ar[mt][ks][0][1]); wv.y = pg8::cvt_pk_bf16(ar[mt][ks][0][2], ar[mt][ks][0][3]); wv.z = pg8::cvt_pk_bf16(ar[mt][ks][1][0], ar[mt][ks][1][1]); wv.w = pg8::cvt_pk_bf16(ar[mt][ks][1][2], ar[mt][ks][1][3]); af[mt][ks] = __builtin_bit_cast(ab8, wv); }
        if (sl + 1 < 16) { CG_LOAD_A(sl + 1); CG_LOAD_B(sl + 1); }
        const LAS unsigned char* bb = F.lds + (sl & 1) * CG_BUF + n * CG_BROW + 16 * q4;
#pragma unroll
        for (int ks = 0; ks < 2; ++ks)
#pragma unroll
            for (int nt = 0; nt < 16; ++nt) { const ab8 bf = *(const LAS ab8*)(bb + nt * 16 * CG_BROW + 64 * ks);
                acc[0][nt] = __builtin_amdgcn_mfma_f32_16x16x32_bf16(bf, af[0][ks], acc[0][nt], 0, 0, 0); acc[1][nt] = __builtin_amdgcn_mfma_f32_16x16x32_bf16(bf, af[1][ks], acc[1][nt], 0, 0, 0); }
        if (sl + 1 < 16) CG_STORE_B((sl + 1) & 1);
        asm volatile("s_waitcnt lgkmcnt(0)" ::: "memory"); __builtin_amdgcn_s_barrier(); asm volatile("" ::: "memory");
    }
#undef CG_LOAD_A
#undef CG_LOAD_B
#undef CG_STORE_B
    bf16* Tm = wsp<bf16>(F, ty ? WS_TV : WS_TK);
#pragma unroll
    for (int mt = 0; mt < 2; ++mt) { bf16* tp = Tm + (size_t)(pm * 256 + 32 * w + 16 * mt + n) * 256 + 4 * q4;
#pragma unroll
        for (int nt = 0; nt < 16; ++nt) { v2u wv; wv.x = pg8::cvt_pk_bf16(acc[mt][nt][0], acc[mt][nt][1]); wv.y = pg8::cvt_pk_bf16(acc[mt][nt][2], acc[mt][nt][3]); *(v2u*)(tp + 16 * nt) = wv; } }
    __syncthreads();
}

constexpr int HRB = 288;
constexpr int HA_Q = 0, HA_KT = 18432, HA_KP = 36864, HA_KH = 55296, HA_V = 73728, HA_A = 92160, HA_TOT = HA_A + 64 * 144, HA_END = HA_TOT + 2048;
static_assert(HA_END <= RING_BYTES, "hgrn A LDS");
DEV ab8 tr_frag(const LAS unsigned char* base, int row0, int colbyte, int n, int q4, int stride) {
    const LAS unsigned char* p = base + (row0 + 8 * q4 + (n >> 2)) * stride + colbyte + 8 * (n & 3);
    const s16x4 lo = vtr(p), hi = vtr(p + 4 * stride);
    return __builtin_shufflevector(lo, hi, 0, 1, 2, 3, 4, 5, 6, 7);
}
struct HgIn { float z[16]; bf16 q[16], v[16]; float lbv; };
DEV void hgrn_a_load(Frame& F, int c, int h, HgIn& in) {
    const int tid = F.tid, k = tid & 127, tq = tid >> 7;
    const float* HF = wsp<float>(F, WS_HF); const bf16* HQ = wsp<bf16>(F, WS_HQ); const bf16* HI = wsp<bf16>(F, WS_HI);
    const size_t g0 = ((size_t)c * 64 + tq * 16) * 512 + h * 128 + k;
#pragma unroll
    for (int i = 0; i < 16; ++i) { in.z[i] = HF[g0 + (size_t)i * 512]; in.q[i] = HQ[g0 + (size_t)i * 512]; in.v[i] = HI[g0 + (size_t)i * 512]; }
    in.lbv = wsp<float>(F, WS_TBL)[TB_LB + h * 128 + k];
}
DEV void hgrn_a_unit(Frame& F, int c, int h, const HgIn& in) {
    LAS unsigned char* L = F.lds;
    const int tid = F.tid, k = tid & 127, tq = tid >> 7, w = F.wave, lane = F.lane, n = lane & 15, q4 = lane >> 4;
    const float* TB = wsp<float>(F, WS_TBL);
    const float* HF = wsp<float>(F, WS_HF); const bf16* HQ = wsp<bf16>(F, WS_HQ); const bf16* HI = wsp<bf16>(F, WS_HI);
    const float lbv = in.lbv, oml = 1.0f - lbv;
    const size_t row0 = (size_t)c * 64; const int col = h * 128 + k;
    LAS float* TOT = (LAS float*)(L + HA_TOT);
    for (int i = tid; i < 64 * 144 / 4; i += 512) ((LAS unsigned*)(L + HA_A))[i] = 0u;
    float bl[16], kt[16], qt[16]; float run = 0.f;
#pragma unroll
    for (int i = 0; i < 16; ++i) { const int t = tq * 16 + i; const size_t g = (row0 + t) * 512 + col;
        const float z = in.z[i]; const float sg = 1.0f / (1.0f + __expf(-z)), sgm = 1.0f / (1.0f + __expf(z));
        run += __logf(lbv + oml * sg); bl[i] = run; kt[i] = oml * sgm; qt[i] = bf2f(in.q[i]); (void)g;
        *(LAS bf16*)(L + HA_V + t * HRB + 2 * k) = in.v[i]; }
    TOT[tq * 128 + k] = run;
#pragma unroll
    for (int i = 0; i < 16; ++i) { const int t = tq * 16 + i; const float kk = kt[i];
        qt[i] = qt[i] * __expf(bl[i]); kt[i] = kk * __expf(run - bl[i]);
        *(LAS bf16*)(L + HA_Q + t * HRB + 2 * k) = (bf16)f2bf(qt[i]); *(LAS bf16*)(L + HA_KT + t * HRB + 2 * k) = (bf16)f2bf(kt[i]);
        *(LAS bf16*)(L + HA_KP + t * HRB + 2 * k) = (bf16)f2bf(kk * __expf(fminf(-bl[i], 80.f))); }
    __syncthreads();
    { float pf = 0.f, sf = 0.f;
#pragma unroll
      for (int j = 0; j < 4; ++j) { const float tj = TOT[j * 128 + k]; if (j < tq) pf += tj; if (j > tq) sf += tj; }
      const float epf = __expf(pf), esf = __expf(sf);
      bf16* HQT = wsp<bf16>(F, WS_HQT);
#pragma unroll
      for (int i = 0; i < 16; ++i) { const int t = tq * 16 + i; *(LAS bf16*)(L + HA_KH + t * HRB + 2 * k) = (bf16)f2bf(kt[i] * esf); HQT[(row0 + t) * 512 + col] = (bf16)f2bf(qt[i] * epf); }
      if (tq == 3) wsp<float>(F, WS_HD)[(size_t)(c * 4 + h) * 128 + k] = __expf(pf + run); }
    for (int id = w; id < 10; id += 8) {
        int ti, si; if (id < 4) { ti = id; si = id; } else if (id < 7) { si = id - 4; ti = si + 1; } else if (id < 9) { si = id - 7; ti = si + 2; } else { si = 0; ti = 3; }
        const LAS unsigned char* qa = L + HA_Q + (16 * ti + n) * HRB + 16 * q4; const LAS unsigned char* kb = L + (id < 4 ? HA_KP : HA_KT) + (16 * si + n) * HRB + 16 * q4;
        f32x4 acc = {0.f, 0.f, 0.f, 0.f};
#pragma unroll
        for (int ks = 0; ks < 4; ++ks) { ab8 a = *(const LAS ab8*)(qa + 64 * ks); const ab8 b = *(const LAS ab8*)(kb + 64 * ks);
            if (id >= 7) {
                v4u aw = __builtin_bit_cast(v4u, a); float f[8] = {bflo(aw.x), bfhi(aw.x), bflo(aw.y), bfhi(aw.y), bflo(aw.z), bfhi(aw.z), bflo(aw.w), bfhi(aw.w)};
#pragma unroll
                for (int e = 0; e < 8; ++e) { const int kk_ = 32 * ks + 8 * q4 + e; float d = TOT[(si + 1) * 128 + kk_]; if (id == 9) d += TOT[2 * 128 + kk_]; f[e] *= __expf(d); }
                aw.x = cvtpk(f[0], f[1]); aw.y = cvtpk(f[2], f[3]); aw.z = cvtpk(f[4], f[5]); aw.w = cvtpk(f[6], f[7]); a = __builtin_bit_cast(ab8, aw); }
            acc = __builtin_amdgcn_mfma_f32_16x16x32_bf16(a, b, acc, 0, 0, 0); }
#pragma unroll
        for (int i = 0; i < 4; ++i) { const float v = (id < 4 && n > 4 * q4 + i) ? 0.f : acc[i]; *(LAS bf16*)(L + HA_A + (16 * ti + 4 * q4 + i) * 144 + 2 * (16 * si + n)) = (bf16)f2bf(v); }
    }
    __syncthreads();
    { const ab8 v0 = tr_frag(L + HA_V, 0, 32 * w, n, q4, HRB), v1 = tr_frag(L + HA_V, 32, 32 * w, n, q4, HRB);
      float* HIN = wsp<float>(F, WS_HIN) + row0 * 512 + h * 128 + 16 * w + 4 * q4;
#pragma unroll
      for (int ti = 0; ti < 4; ++ti) { const LAS unsigned char* ap = L + HA_A + (16 * ti + n) * 144 + 16 * q4;
          f32x4 acc = {0.f, 0.f, 0.f, 0.f};
          acc = __builtin_amdgcn_mfma_f32_16x16x32_bf16(v0, *(const LAS ab8*)ap, acc, 0, 0, 0);
          if (ti >= 2) acc = __builtin_amdgcn_mfma_f32_16x16x32_bf16(v1, *(const LAS ab8*)(ap + 64), acc, 0, 0, 0);
          *(f32x4*)(HIN + (size_t)(16 * ti + n) * 512) = acc; }
      bf16* HL = wsp<bf16>(F, WS_HL) + (size_t)(c * 4 + h) * 16384 + 16 * w + 4 * q4;
#pragma unroll
      for (int kt_ = 0; kt_ < 8; ++kt_) { const ab8 k0 = tr_frag(L + HA_KH, 0, 32 * kt_, n, q4, HRB), k1 = tr_frag(L + HA_KH, 32, 32 * kt_, n, q4, HRB);
          f32x4 acc = {0.f, 0.f, 0.f, 0.f};
          acc = __builtin_amdgcn_mfma_f32_16x16x32_bf16(v0, k0, acc, 0, 0, 0); acc = __builtin_amdgcn_mfma_f32_16x16x32_bf16(v1, k1, acc, 0, 0, 0);
          v2u wv; wv.x = cvtpk(acc[0], acc[1]); wv.y = cvtpk(acc[2], acc[3]); *(v2u*)(HL + (size_t)(16 * kt_ + n) * 128) = wv; } }
    __syncthreads();
}
DEV void hgrn_sample_unit(Frame& F, int b, int h) {
    LAS float* Lf = (LAS float*)F.lds;
    LAS float* Lkk = Lf + 512;
    LAS float* Lqq = Lkk + 512;
    LAS float* Lo = Lqq + 512;
    LAS float* Lot = Lo + 512;
    const int tid = F.tid, v = tid & 127, kq = tid >> 7;
    const float* TB = wsp<float>(F, WS_TBL);
    const float* HF = wsp<float>(F, WS_HF); const bf16* HQ = wsp<bf16>(F, WS_HQ); const bf16* HI = wsp<bf16>(F, WS_HI);
    { const int k = v, t = kq; const size_t g = (size_t)(T + b * 4 + t) * 512 + h * 128 + k; const float lbv = TB[TB_LB + h * 128 + k], oml = 1.0f - lbv;
      const float z = HF[g]; Lf[t * 128 + k] = lbv + oml / (1.0f + __expf(-z)); Lkk[t * 128 + k] = oml / (1.0f + __expf(z)); Lqq[t * 128 + k] = bf2f(HQ[g]); }
    float S[32];
    const float* S0 = ((const float*)F.A.in[8]) + ((size_t)(b * 4 + h) * 128 + kq * 32) * 128 + v;
#pragma unroll
    for (int j = 0; j < 32; ++j) S[j] = S0[(size_t)j * 128];
    __syncthreads();
    for (int t = 0; t < 4; ++t) {
        const float vt = bf2f(HI[(size_t)(T + b * 4 + t) * 512 + h * 128 + v]);
        float o = 0.f;
#pragma unroll
        for (int j = 0; j < 32; ++j) { const int k = kq * 32 + j; S[j] = Lf[t * 128 + k] * S[j] + Lkk[t * 128 + k] * vt; o += Lqq[t * 128 + k] * S[j]; }
        Lo[kq * 128 + v] = o;
        __syncthreads();
        if (kq == 0) Lot[t * 128 + v] = (Lo[v] + Lo[128 + v]) + (Lo[256 + v] + Lo[384 + v]);
        __syncthreads();
    }
    float* So = F.out + O_SH + ((size_t)(b * 4 + h) * 128 + kq * 32) * 128 + v;
#pragma unroll
    for (int j = 0; j < 32; ++j) So[(size_t)j * 128] = S[j];
    if (F.wave < 4) {
        const int t = F.wave, lane = F.lane; const f32x2 o = *(const LAS f32x2*)(Lot + t * 128 + 2 * lane);
        const float ss = wave_sum(o.x * o.x + o.y * o.y); const float rr = 1.0f / sqrtf(ss * (1.f / 128.f) + EPS);
        const size_t go = (size_t)(T + b * 4 + t) * 512 + h * 128 + 2 * lane; const unsigned gw_ = *(const unsigned*)(wsp<bf16>(F, WS_HG) + go);
        *(unsigned*)(wsp<bf16>(F, WS_OB) + go) = pk2(o.x * rr * ((const float*)F.A.in[20])[2 * lane] * bflo(gw_), o.y * rr * ((const float*)F.A.in[20])[2 * lane + 1] * bfhi(gw_)); }
    __syncthreads();
}
DEV void cmp_prompt_unit(Frame& F, int u) {
    const int ty = u >> 7, kv = (u >> 6) & 1, i0 = (u & 63) * 16, tid = F.tid, w = F.wave;
    int lane = F.lane; asm volatile("" : "+v"(lane));
    const int n = lane & 15, q4 = lane >> 4;
    LAS float* Lg = (LAS float*)F.lds;
    LAS float* w2s = Lg + 16 * 128;
    LAS float* part = w2s + 128 * 64;
    { const float* w2g = ty ? ((const float*)F.A.in[17]) : ((const float*)F.A.in[14]);
#pragma unroll
      for (int j = 0; j < 4; ++j) *(LAS f32x4*)(w2s + 4 * (tid + 512 * j)) = *(const f32x4*)(w2g + 4 * (tid + 512 * j)); }
    const bf16* ap = wsp<bf16>(F, ty ? WS_CVP : WS_CKP) + (size_t)(kv * 1024 + i0 + n) * 1024 + 256 * w + 8 * q4;
    const bf16* bp = wsp<bf16>(F, ty ? WS_W1PV : WS_W1PK) + (size_t)(8 * w) * 512 + lane * 8;
    ab8 af[8];
#pragma unroll
    for (int ks = 0; ks < 8; ++ks) af[ks] = *(const ab8*)(ap + 32 * ks);
#pragma unroll
    for (int ct = 0; ct < 8; ++ct) { f32x4 acc = {0.f, 0.f, 0.f, 0.f};
#pragma unroll
        for (int ks = 0; ks < 8; ++ks) acc = __builtin_amdgcn_mfma_f32_16x16x32_bf16(af[ks], *(const ab8*)(bp + (size_t)(ct * 64 + ks) * 512), acc, 0, 0, 0);
#pragma unroll
        for (int r = 0; r < 4; ++r) part[(w * 16 + 4 * q4 + r) * 128 + 16 * ct + n] = acc[r]; }
    __syncthreads();
    { const float* hb = wsp<float>(F, WS_CTL) + CTL_HB + ty * 128;
#pragma unroll
      for (int j = 0; j < 4; ++j) { const int o = tid + 512 * j; float sum = hb[o & 127];
#pragma unroll
          for (int ww = 0; ww < 8; ++ww) sum += part[ww * 2048 + o];
          Lg[o] = gelu_tanh(sum); } }
    __syncthreads();
#pragma unroll
    for (int j = 0; j < 2; ++j) { const int o = tid + 512 * j, blk = o >> 6, d = o & 63, i = i0 + blk; float s0 = 0.f, s1 = 0.f, s2 = 0.f, s3 = 0.f;
#pragma unroll 8
        for (int e = 0; e < 128; e += 4) { const f32x4 g = *(const LAS f32x4*)(Lg + blk * 128 + e);
            s0 += g[0] * w2s[e * 64 + d]; s1 += g[1] * w2s[(e + 1) * 64 + d]; s2 += g[2] * w2s[(e + 2) * 64 + d]; s3 += g[3] * w2s[(e + 3) * 64 + d]; }
        if (i < NCB) wsp<bf16>(F, ty ? WS_VCP : WS_KCP)[(size_t)(i * 2 + kv) * 64 + d] = (bf16)f2bf((s0 + s1) + (s2 + s3)); }
    __syncthreads();
}
DEV void cmp_sample_task(Frame& F, int tsk) {
    const int ty = tsk >> 12, rem = tsk & 4095, bk = rem >> 6;
    int lane = F.lane; asm volatile("" : "+v"(lane));
    const int n = lane & 15, q4 = lane >> 4, i = (rem & 63) * 16 + n;
    const bool valid = i < NCB;
    const bf16* Tm = wsp<bf16>(F, ty ? WS_TV : WS_TK);
    const float* hb = wsp<float>(F, WS_CTL) + CTL_HB + ty * 128 + 8 * q4;
    const size_t r = ((size_t)(bk >> 1) * 1024 + (valid ? i : 0)) * 2 + (bk & 1);
    const bf16* t0 = Tm + r * 256 + 8 * q4; const bf16* t1 = Tm + (r + 2) * 256 + 128 + 8 * q4;
    const bf16* W2T = wsp<bf16>(F, ty ? WS_W2V : WS_W2K) + (size_t)n * 128 + 8 * q4;
    f32x4 acc[4];
#pragma unroll
    for (int dt = 0; dt < 4; ++dt) acc[dt] = (f32x4){0.f, 0.f, 0.f, 0.f};
#pragma unroll
    for (int ks = 0; ks < 4; ++ks) {
        const v4u a = *(const v4u*)(t0 + 32 * ks), b = *(const v4u*)(t1 + 32 * ks); const f32x4 h0 = *(const f32x4*)(hb + 32 * ks), h1 = *(const f32x4*)(hb + 32 * ks + 4);
        v4u gw; gw.x = cvtpk(gelu_tanh(bflo(a.x) + bflo(b.x) + h0[0]), gelu_tanh(bfhi(a.x) + bfhi(b.x) + h0[1])); gw.y = cvtpk(gelu_tanh(bflo(a.y) + bflo(b.y) + h0[2]), gelu_tanh(bfhi(a.y) + bfhi(b.y) + h0[3]));
        gw.z = cvtpk(gelu_tanh(bflo(a.z) + bflo(b.z) + h1[0]), gelu_tanh(bfhi(a.z) + bfhi(b.z) + h1[1])); gw.w = cvtpk(gelu_tanh(bflo(a.w) + bflo(b.w) + h1[2]), gelu_tanh(bfhi(a.w) + bfhi(b.w) + h1[3]));
        const ab8 gf = __builtin_bit_cast(ab8, gw);
#pragma unroll
        for (int dt = 0; dt < 4; ++dt) acc[dt] = __builtin_amdgcn_mfma_f32_16x16x32_bf16(*(const ab8*)(W2T + (size_t)dt * 16 * 128 + 32 * ks), gf, acc[dt], 0, 0, 0);
    }
    if (valid) { bf16* dst = wsp<bf16>(F, ty ? WS_VCS : WS_KCS) + r * 64 + 4 * q4;
#pragma unroll
        for (int dt = 0; dt < 4; ++dt) { v2u wv; wv.x = cvtpk(acc[dt][0], acc[dt][1]); wv.y = cvtpk(acc[dt][2], acc[dt][3]); *(v2u*)(dst + 16 * dt) = wv; } }
}
DEV void p2_phase(Frame& F) {
    for (int rep = 0; rep < ((PROBE_REP >> 21) & 1) + 1; ++rep) {
        HgIn cur, nxt; if (F.vcu < 1024) hgrn_a_load(F, F.vcu >> 2, F.vcu & 3, cur);
        for (int u = F.vcu; u < 1024; u += F.G) { const int un = u + F.G < 1024 ? u + F.G : u; hgrn_a_load(F, un >> 2, un & 3, nxt); hgrn_a_unit(F, u >> 2, u & 3, cur); cur = nxt; } }
    for (int rep = 0; rep < ((PROBE_REP >> 23) & 1) + 1; ++rep) for (int u = F.vcu; u < 256; u += F.G) cmp_prompt_unit(F, u);
    for (int rep = 0; rep < ((PROBE_REP >> 24) & 1) + 1; ++rep) {
        for (int tsk = F.vcu * 8 + F.wave; tsk < 8192; tsk += F.G * 8) cmp_sample_task(F, tsk); }
    __syncthreads();
}

DEV void hgrn_scan(Frame& F) {
    if (F.vcu >= 64) return;
    const int e2 = F.vcu * 512 + F.tid, e = 2 * e2, h = e >> 14, k = (e >> 7) & 127;
    unsigned* HL = (unsigned*)wsp<bf16>(F, WS_HL) + e2; const float* HD = wsp<float>(F, WS_HD) + h * 128 + k;
    float s0 = 0.f, s1 = 0.f;
#pragma unroll 1
    for (int c0 = 0; c0 < 256; c0 += 32) {
        unsigned Lv[32]; float dv[32];
#pragma unroll
        for (int j = 0; j < 32; ++j) { Lv[j] = HL[(size_t)(c0 + j) * 32768]; dv[j] = HD[(c0 + j) * 512]; }
#pragma unroll
        for (int j = 0; j < 32; ++j) { HL[(size_t)(c0 + j) * 32768] = pk2(s0, s1); s0 = dv[j] * s0 + bflo(Lv[j]); s1 = dv[j] * s1 + bfhi(Lv[j]); }
    }
    *(f32x2*)(F.out + O_PH + e) = (f32x2){s0, s1};
}


constexpr int TROW = 128, TILEB = 64 * TROW;
DEV int swz(int row, int chunk) { return row * TROW + ((chunk ^ (row & 7)) << 4); }
constexpr int SCS = 260;
constexpr int SEL_SLOTS = 6;
constexpr int DMA_SLOTS_C = 3;
constexpr int AT_SC = DMA_SLOTS_C * 2 * TILEB;
constexpr int AT_MSK = AT_SC + 64 * SCS * 4;
constexpr int DMA_SLOTS_W = AT_MSK / (2 * TILEB) < 6 ? AT_MSK / (2 * TILEB) : 6;
constexpr int AT_LST = AT_MSK + 2064;
constexpr int AT_LUT = AT_LST + 1056;
constexpr int AT_END = AT_LUT + 8 * 129 * 4;
static_assert(AT_END <= RING_BYTES && AT_SC % 16 == 0 && AT_MSK % 16 == 0 && AT_LST % 16 == 0 && SEL_SLOTS * 2 * TILEB <= AT_MSK && DMA_SLOTS_W >= 3, "attention unit LDS");
constexpr float QSCALE = 0.125f * LOG2E;


struct AttnCtx {
    const LAS float* lut;
    int n, q4, h;
    int tq[2];
    float b31;
};
DEV void qk64(const LAS unsigned char* Kb, const AttnCtx& C, const ab8 (&qf)[2][2], f32x4 (&s)[2][4], float init0, float init1, bool a0, bool a1) {
    ab8 k0[4], k1[4];
#pragma unroll
    for (int kt = 0; kt < 4; ++kt) { k0[kt] = *(const LAS ab8*)(Kb + swz(16 * kt + C.n, C.q4)); k1[kt] = *(const LAS ab8*)(Kb + swz(16 * kt + C.n, 4 + C.q4)); }
    __builtin_amdgcn_sched_barrier(0);
#pragma unroll
    for (int kt = 0; kt < 4; ++kt) {
        if (a0) { f32x4 c = {init0, init0, init0, init0}; c = __builtin_amdgcn_mfma_f32_16x16x32_bf16(k0[kt], qf[0][0], c, 0, 0, 0); s[0][kt] = __builtin_amdgcn_mfma_f32_16x16x32_bf16(k1[kt], qf[0][1], c, 0, 0, 0); }
        if (a1) { f32x4 c = {init1, init1, init1, init1}; c = __builtin_amdgcn_mfma_f32_16x16x32_bf16(k0[kt], qf[1][0], c, 0, 0, 0); s[1][kt] = __builtin_amdgcn_mfma_f32_16x16x32_bf16(k1[kt], qf[1][1], c, 0, 0, 0); }
    }
}
template <bool LUTB, bool WINLO>
DEV void mask_bias(f32x4 (&s)[4], const AttnCtx& C, int t, int p0, int pstep, bool colok) {
#pragma unroll
    for (int kt = 0; kt < 4; ++kt)
#pragma unroll
        for (int i = 0; i < 4; ++i) { const int rel = t - (p0 + pstep * (16 * kt + 4 * C.q4 + i));
            bool ok = colok && rel >= 0; if (WINLO) ok = ok && rel < 512;
            float v = s[kt][i]; if (LUTB) v += C.lut[C.h * 129 + (rel < 0 ? 0 : (rel < 128 ? rel : 128))];
            s[kt][i] = ok ? v : NEG_INF; }
}
DEV float colmax16(const f32x4 (&s)[4]) {
    float mx = fmaxf(fmaxf(s[0][0], s[0][1]), fmaxf(s[0][2], s[0][3]));
#pragma unroll
    for (int kt = 1; kt < 4; ++kt) mx = fmaxf(mx, fmaxf(fmaxf(s[kt][0], s[kt][1]), fmaxf(s[kt][2], s[kt][3])));
    mx = fmaxf(mx, __shfl_xor(mx, 16)); mx = fmaxf(mx, __shfl_xor(mx, 32));
    return mx;
}
DEV void online_step(f32x4 (&s)[4], float& m, float& l, f32x4 (&O)[4], ab8 (&pf)[2]) {
    const float mx = colmax16(s), mn = fmaxf(m, mx), ms = (mn == NEG_INF) ? 0.f : mn;
    const float sc = __builtin_amdgcn_exp2f(m - ms);
    float ps = 0.f;
#pragma unroll
    for (int kt = 0; kt < 4; ++kt)
#pragma unroll
        for (int i = 0; i < 4; ++i) { const float p = __builtin_amdgcn_exp2f(s[kt][i] - ms); s[kt][i] = p; ps += p; }
    l = l * sc + ps; m = mn;
#pragma unroll
    for (int dt = 0; dt < 4; ++dt) O[dt] = O[dt] * sc;
#pragma unroll
    for (int j = 0; j < 2; ++j) { v4u w; w.x = cvtpk(s[2 * j][0], s[2 * j][1]); w.y = cvtpk(s[2 * j][2], s[2 * j][3]); w.z = cvtpk(s[2 * j + 1][0], s[2 * j + 1][1]); w.w = cvtpk(s[2 * j + 1][2], s[2 * j + 1][3]); pf[j] = __builtin_bit_cast(ab8, w); }
}
DEV void ref_step(f32x4 (&s)[4], float& m, f32x4 (&O)[4], f32x4& L, ab8 (&pf)[2], bool colact) {
    float mx = fmaxf(fmaxf(s[0][0], s[0][1]), fmaxf(s[0][2], s[0][3]));
#pragma unroll
    for (int kt = 1; kt < 4; ++kt) mx = fmaxf(mx, fmaxf(fmaxf(s[kt][0], s[kt][1]), fmaxf(s[kt][2], s[kt][3])));
    const bool slow = (colact && m == NEG_INF) || mx > 64.f;
    if (__any(slow)) {
        mx = fmaxf(mx, __shfl_xor(mx, 16)); mx = fmaxf(mx, __shfl_xor(mx, 32));
        const bool un = (m == NEG_INF);
        const float d = (mx == NEG_INF) ? 0.f : (un ? mx : fmaxf(mx, 0.f));
        const float sc = un ? 1.f : __builtin_amdgcn_exp2f(-d);
#pragma unroll
        for (int kt = 0; kt < 4; ++kt) s[kt] = s[kt] - d;
#pragma unroll
        for (int dt = 0; dt < 4; ++dt) O[dt] = O[dt] * sc;
        L = L * sc;
        m = un ? ((mx == NEG_INF) ? NEG_INF : mx) : m + d;
    }
#pragma unroll
    for (int kt = 0; kt < 4; ++kt)
#pragma unroll
        for (int i = 0; i < 4; ++i) s[kt][i] = __builtin_amdgcn_exp2f(s[kt][i]);
#pragma unroll
    for (int j = 0; j < 2; ++j) { v4u w; w.x = cvtpk(s[2 * j][0], s[2 * j][1]); w.y = cvtpk(s[2 * j][2], s[2 * j][3]); w.z = cvtpk(s[2 * j + 1][0], s[2 * j + 1][1]); w.w = cvtpk(s[2 * j + 1][2], s[2 * j + 1][3]); pf[j] = __builtin_bit_cast(ab8, w); }
}
DEV float cinit(float bias, float m, bool colact) { return colact ? bias - ((m == NEG_INF) ? 0.f : m) : NEG_INF; }
template <bool PV, bool WITHL>
DEV void pv64(const LAS unsigned char* Vb, const AttnCtx& C, const ab8 (&pf)[2][2], f32x4 (&O)[2][4], f32x4 (&L)[2], bool a0, bool a1) {
    if (PV) {
        const int vr = 4 * C.q4 + (C.n >> 2), vc = (C.n & 3) >> 1, vs = 8 * (C.n & 1);
        ab8 vf[4][2];
#pragma unroll
        for (int dt = 0; dt < 4; ++dt)
#pragma unroll
            for (int j = 0; j < 2; ++j) {
                const s16x4 lo = vtr(Vb + swz(32 * j + vr, 2 * dt + vc) + vs), hi = vtr(Vb + swz(32 * j + 16 + vr, 2 * dt + vc) + vs);
                vf[dt][j] = __builtin_shufflevector(lo, hi, 0, 1, 2, 3, 4, 5, 6, 7); }
        __builtin_amdgcn_sched_barrier(0);
#pragma unroll
        for (int dt = 0; dt < 4; ++dt)
#pragma unroll
            for (int j = 0; j < 2; ++j) {
                if (a0) O[0][dt] = __builtin_amdgcn_mfma_f32_16x16x32_bf16(vf[dt][j], pf[0][j], O[0][dt], 0, 0, 0);
                if (a1) O[1][dt] = __builtin_amdgcn_mfma_f32_16x16x32_bf16(vf[dt][j], pf[1][j], O[1][dt], 0, 0, 0); }
    }
    if (WITHL) {
        const short one = (C.n == 0) ? (short)0x3F80 : (short)0; const ab8 ones = {one, one, one, one, one, one, one, one};
#pragma unroll
        for (int j = 0; j < 2; ++j) {
            if (a0) L[0] = __builtin_amdgcn_mfma_f32_16x16x32_bf16(ones, pf[0][j], L[0], 0, 0, 0);
            if (a1) L[1] = __builtin_amdgcn_mfma_f32_16x16x32_bf16(ones, pf[1][j], L[1], 0, 0, 0);
        }
    }
}
DEV void pv_load(const LAS unsigned char* Vb, const AttnCtx& C, ab8 (&vf)[4][2]) {
    const int vr = 4 * C.q4 + (C.n >> 2), vc = (C.n & 3) >> 1, vs = 8 * (C.n & 1);
#pragma unroll
    for (int dt = 0; dt < 4; ++dt)
#pragma unroll
        for (int j = 0; j < 2; ++j) {
            const s16x4 lo = vtr(Vb + swz(32 * j + vr, 2 * dt + vc) + vs), hi = vtr(Vb + swz(32 * j + 16 + vr, 2 * dt + vc) + vs);
            vf[dt][j] = __builtin_shufflevector(lo, hi, 0, 1, 2, 3, 4, 5, 6, 7); }
}
DEV void pv_mma(const AttnCtx& C, const ab8 (&vf)[4][2], const ab8 (&pf)[2][2], f32x4 (&O)[2][4], f32x4 (&L)[2], bool a0, bool a1) {
#pragma unroll
    for (int dt = 0; dt < 4; ++dt)
#pragma unroll
        for (int j = 0; j < 2; ++j) {
            if (a0) O[0][dt] = __builtin_amdgcn_mfma_f32_16x16x32_bf16(vf[dt][j], pf[0][j], O[0][dt], 0, 0, 0);
            if (a1) O[1][dt] = __builtin_amdgcn_mfma_f32_16x16x32_bf16(vf[dt][j], pf[1][j], O[1][dt], 0, 0, 0); }
    const short one = (C.n == 0) ? (short)0x3F80 : (short)0; const ab8 ones = {one, one, one, one, one, one, one, one};
#pragma unroll
    for (int j = 0; j < 2; ++j) {
        if (a0) L[0] = __builtin_amdgcn_mfma_f32_16x16x32_bf16(ones, pf[0][j], L[0], 0, 0, 0);
        if (a1) L[1] = __builtin_amdgcn_mfma_f32_16x16x32_bf16(ones, pf[1][j], L[1], 0, 0, 0); }
}
DEV void tile_issue(const bf16* Kg, const bf16* Vg, int row0, int tid, v4u& rk, v4u& rv, bool withV) {
    const size_t off = (size_t)(row0 + (tid >> 3)) * 128 + (tid & 7) * 8;
    rk = *(const v4u*)(Kg + off); if (withV) rv = *(const v4u*)(Vg + off);
}
DEV void tile_commit(LAS unsigned char* buf, int tid, const v4u rk, const v4u rv, bool withV) {
    LAS unsigned char* d = buf + swz(tid >> 3, tid & 7);
    *(LAS v4u*)d = rk; if (withV) *(LAS v4u*)(d + TILEB) = rv;
}
template <class RowFn, class Compute>
DEV void stream_tiles(Frame& F, int n, const bf16* Kg, const bf16* Vg, bool withV, RowFn rowfn, Compute compute) {
    if (n <= 0) return;
    v4u rk, rv = {0u, 0u, 0u, 0u};
    tile_issue(Kg, Vg, rowfn(0), F.tid, rk, rv, withV); tile_commit(F.lds, F.tid, rk, rv, withV);
    __syncthreads();
    for (int i = 0; i < n; ++i) {
        LAS unsigned char* cur = F.lds + (i & 1) * 2 * TILEB; LAS unsigned char* nxt = F.lds + ((i + 1) & 1) * 2 * TILEB;
        const bool more = i + 1 < n;
        if (more) tile_issue(Kg, Vg, rowfn(i + 1), F.tid, rk, rv, withV);
        compute(i, cur, cur + TILEB);
        if (more) tile_commit(nxt, F.tid, rk, rv, withV);
        __syncthreads();
    }
}
template <int S, bool WITHV, class RowFn, class Compute>
DEV void stream_tiles_dma(Frame& F, int n, const bf16* Kg, const bf16* Vg, RowFn rowfn, Compute compute) {
    if (n <= 0) return;
    int tid = F.tid; asm volatile("" : "+v"(tid));
    const unsigned goff = (unsigned)((tid >> 3) * 256 + (((tid & 7) ^ ((tid >> 3) & 7)) << 4));
    LAS unsigned char* lbase = F.lds + F.wave * 1024;
    constexpr int L = WITHV ? 2 : 1;
#define SD_ISSUE(t) do { const int t_ = (t); LAS unsigned char* d_ = lbase + (t_ % S) * 2 * TILEB; const size_t gb_ = (size_t)rowfn(t_) * 256 + goff; \
        __builtin_amdgcn_global_load_lds((const unsigned*)((const char*)Kg + gb_), (LAS unsigned*)d_, 16, 0, 0); \
        if (WITHV) __builtin_amdgcn_global_load_lds((const unsigned*)((const char*)Vg + gb_), (LAS unsigned*)(d_ + TILEB), 16, 0, 0); } while (0)
    for (int t = 0; t < S - 1 && t < n; ++t) SD_ISSUE(t);
    for (int i = 0; i < n; ++i) {
        const int ahead = (n - 1 - i) < (S - 2) ? (n - 1 - i) : (S - 2);
        static_assert(S >= 2 && S <= 6, "stream_tiles_dma slots");
        if (ahead * L >= 8) asm volatile("s_waitcnt vmcnt(8)" ::: "memory"); else if (ahead * L == 6) asm volatile("s_waitcnt vmcnt(6)" ::: "memory");
        else if (ahead * L == 4) asm volatile("s_waitcnt vmcnt(4)" ::: "memory"); else if (ahead * L == 3) asm volatile("s_waitcnt vmcnt(3)" ::: "memory");
        else if (ahead * L == 2) asm volatile("s_waitcnt vmcnt(2)" ::: "memory"); else if (ahead * L == 1) asm volatile("s_waitcnt vmcnt(1)" ::: "memory");
        else asm volatile("s_waitcnt vmcnt(0)" ::: "memory");
        __builtin_amdgcn_s_barrier(); asm volatile("" ::: "memory");
        if (i + S - 1 < n) SD_ISSUE(i + S - 1);
        const LAS unsigned char* cur = F.lds + (i % S) * 2 * TILEB;
        compute(i, cur, cur + TILEB);
    }
#undef SD_ISSUE
    asm volatile("" ::: "memory"); __builtin_amdgcn_s_barrier(); asm volatile("" ::: "memory");
}
template <int NB, class RowFn, class Compute>
DEV void stream_stages_dma(Frame& F, int n, const bf16* Kg, const bf16* Vg, RowFn rowfn, Compute compute) {
    if (n <= 0) return;
    int tid = F.tid; asm volatile("" : "+v"(tid));
    const unsigned goff = (unsigned)((tid >> 3) * 256 + (((tid & 7) ^ ((tid >> 3) & 7)) << 4));
    LAS unsigned char* lbase = F.lds + F.wave * 1024;
#define SS_ISSUE(t, slot) do { LAS unsigned char* d_ = lbase + (slot) * 2 * TILEB; const size_t gb_ = (size_t)rowfn(t) * 256 + goff; \
        __builtin_amdgcn_global_load_lds((const unsigned*)((const char*)Kg + gb_), (LAS unsigned*)d_, 16, 0, 0); \
        __builtin_amdgcn_global_load_lds((const unsigned*)((const char*)Vg + gb_), (LAS unsigned*)(d_ + TILEB), 16, 0, 0); } while (0)
#pragma unroll
    for (int b = 0; b < NB; ++b) if (b < n) SS_ISSUE(b, b);
    for (int i0 = 0, st = 0; i0 < n; i0 += NB, st ^= 1) {
        asm volatile("s_waitcnt vmcnt(0)" ::: "memory");
        __builtin_amdgcn_s_barrier(); asm volatile("" ::: "memory");
#pragma unroll
        for (int b = 0; b < NB; ++b) if (i0 + NB + b < n) SS_ISSUE(i0 + NB + b, (st ^ 1) * NB + b);
        const LAS unsigned char* cur = F.lds + st * NB * 2 * TILEB;
#pragma unroll
        for (int b = 0; b < NB; ++b) if (i0 + b < n) compute(i0 + b, cur + b * 2 * TILEB, cur + b * 2 * TILEB + TILEB);
    }
#undef SS_ISSUE
    asm volatile("" ::: "memory"); __builtin_amdgcn_s_barrier(); asm volatile("" ::: "memory");
}
template <int NB, class RowFn, class Compute>
DEV void stream_tiles_multi(Frame& F, int n, const bf16* Kg, const bf16* Vg, RowFn rowfn, Compute compute) {
    if (n <= 0) return;
    v4u rk[NB], rv[NB];
#pragma unroll
    for (int b = 0; b < NB; ++b) if (b < n) { tile_issue(Kg, Vg, rowfn(b), F.tid, rk[b], rv[b], true); }
#pragma unroll
    for (int b = 0; b < NB; ++b) if (b < n) tile_commit(F.lds + b * 2 * TILEB, F.tid, rk[b], rv[b], true);
    __syncthreads();
    for (int i0 = 0, st = 0; i0 < n; i0 += NB, st ^= 1) {
        LAS unsigned char* cur = F.lds + st * NB * 2 * TILEB; LAS unsigned char* nxt = F.lds + (st ^ 1) * NB * 2 * TILEB;
#pragma unroll
        for (int b = 0; b < NB; ++b) if (i0 + NB + b < n) tile_issue(Kg, Vg, rowfn(i0 + NB + b), F.tid, rk[b], rv[b], true);
#pragma unroll
        for (int b = 0; b < NB; ++b) if (i0 + b < n) compute(i0 + b, cur + b * 2 * TILEB, cur + b * 2 * TILEB + TILEB);
#pragma unroll
        for (int b = 0; b < NB; ++b) if (i0 + NB + b < n) tile_commit(nxt + b * 2 * TILEB, F.tid, rk[b], rv[b], true);
        __syncthreads();
    }
}
template <int CTRL> DEV unsigned dpp_u32(unsigned v) { return (unsigned)__builtin_amdgcn_update_dpp(0, (int)v, CTRL, 0xF, 0xF, false); }
DEV unsigned wave_max_u32(unsigned v) {
    v = max(v, dpp_u32<0x128>(v)); v = max(v, dpp_u32<0x124>(v)); v = max(v, dpp_u32<0x122>(v)); v = max(v, dpp_u32<0x121>(v));
    v = max(v, (unsigned)__shfl_xor((int)v, 16)); v = max(v, (unsigned)__shfl_xor((int)v, 32));
    return v;
}
template <int NQ>
DEV void select_queries(const LAS float* score, int cur, int q0, LAS unsigned* msk, int lane) {
    unsigned key[NQ][4];
#pragma unroll
    for (int ql = 0; ql < NQ; ++ql)
#pragma unroll
        for (int mm = 0; mm < 4; ++mm) { const int j = lane + 64 * mm; key[ql][mm] = (j >= 1 && j <= cur - 2) ? ((__float_as_uint(score[(q0 + ql) * SCS + j]) & 0xFFFFFF00u) | (unsigned)(255 - j)) : 0u; }
    const int ns = cur >= 2 ? 3 : cur + 1;
    const int ncand = cur - 2 > 0 ? cur - 2 : 0;
    if (lane == 0) {
#pragma unroll
        for (int ql = 0; ql < NQ; ++ql) { const int q = q0 + ql; const unsigned bit = 1u << (q & 31); LAS unsigned* mw = msk + (q >> 5);
            __hip_atomic_fetch_or(mw, bit, __ATOMIC_RELAXED, __HIP_MEMORY_SCOPE_WORKGROUP);
            if (cur >= 1) __hip_atomic_fetch_or(mw + 2 * cur, bit, __ATOMIC_RELAXED, __HIP_MEMORY_SCOPE_WORKGROUP);
            if (cur >= 2) __hip_atomic_fetch_or(mw + 2 * (cur - 1), bit, __ATOMIC_RELAXED, __HIP_MEMORY_SCOPE_WORKGROUP); }
    }
    if (ncand <= 16 - ns) {
        if (lane < ncand) {
#pragma unroll
            for (int ql = 0; ql < NQ; ++ql) { const int q = q0 + ql; __hip_atomic_fetch_or(msk + (q >> 5) + 2 * (1 + lane), 1u << (q & 31), __ATOMIC_RELAXED, __HIP_MEMORY_SCOPE_WORKGROUP); } }
        return;
    }
    for (int it = ns; it < 16; ++it) {
        unsigned best[NQ];
#pragma unroll
        for (int ql = 0; ql < NQ; ++ql) best[ql] = max(max(key[ql][0], key[ql][1]), max(key[ql][2], key[ql][3]));
#pragma unroll
        for (int ql = 0; ql < NQ; ++ql) best[ql] = wave_max_u32(best[ql]);
#pragma unroll
        for (int ql = 0; ql < NQ; ++ql) {
#pragma unroll
            for (int mm = 0; mm < 4; ++mm) key[ql][mm] = (key[ql][mm] == best[ql]) ? 0u : key[ql][mm];
            if (lane == 0) { const int q = q0 + ql, jw = 255 - (int)(best[ql] & 0xFFu); __hip_atomic_fetch_or(msk + (q >> 5) + 2 * jw, 1u << (q & 31), __ATOMIC_RELAXED, __HIP_MEMORY_SCOPE_WORKGROUP); } }
    }
}

DEV void attn_unit_mfma(Frame& F, int qg, int kv) {
    int lane = F.lane; asm volatile("" : "+v"(lane));
    const int w = F.wave, tid = F.tid, t0 = qg * 64, cur = qg;
    AttnCtx C; C.n = lane & 15; C.q4 = lane >> 4; C.h = C.n & 3;
    C.lut = (const LAS float*)(F.lds + AT_LUT) + kv * 4 * 129;
    C.tq[0] = t0 + 8 * w + (C.n >> 2); C.tq[1] = C.tq[0] + 4;
    C.b31 = C.lut[C.h * 129 + 128];
    LAS float* score = (LAS float*)(F.lds + AT_SC); LAS unsigned* msk = (LAS unsigned*)(F.lds + AT_MSK); LAS int* lst = (LAS int*)(F.lds + AT_LST);
    ab8 qf[2][2];
    { const bf16* QA = wsp<bf16>(F, WS_QA) + (size_t)(kv * 4 + C.h) * 64 + 8 * C.q4;
#pragma unroll
      for (int g = 0; g < 2; ++g)
#pragma unroll
          for (int ks = 0; ks < 2; ++ks) qf[g][ks] = *(const ab8*)(QA + (size_t)C.tq[g] * 512 + 32 * ks); }
    for (int i = tid; i < 64 * SCS; i += 512) score[i] = 0.f;
    for (int i = tid; i < 516; i += 512) msk[i] = 0u;
    float* ACC = wsp<float>(F, WS_PT);
    const float* GA = wsp<float>(F, WS_GA);
    float m[2]; f32x4 O[2][4], L[2];
#define RESET_STATE() do { _Pragma("unroll") for (int g = 0; g < 2; ++g) { m[g] = NEG_INF; L[g] = (f32x4){0.f, 0.f, 0.f, 0.f}; _Pragma("unroll") for (int dt = 0; dt < 4; ++dt) O[g][dt] = (f32x4){0.f, 0.f, 0.f, 0.f}; } } while (0)
#define ACC_AT(g, dt) (ACC + (size_t)C.tq[g] * 512 + (kv * 4 + C.h) * 64 + 16 * (dt) + 4 * C.q4)
#define FOLD_BRANCH(br) do { _Pragma("unroll") for (int g = 0; g < 2; ++g) { const float lt = __shfl(L[g][0], C.n); \
        const float gsc = (lt > 0.f) ? GA[(size_t)C.tq[g] * 24 + (kv * 4 + C.h) * 3 + (br)] / lt : 0.f; _Pragma("unroll") for (int dt = 0; dt < 4; ++dt) { f32x4* ap_ = (f32x4*)ACC_AT(g, dt); *ap_ = *ap_ + O[g][dt] * gsc; } } } while (0)

    const bf16* KC = wsp<bf16>(F, WS_KCP) + kv * 64; const bf16* VC = wsp<bf16>(F, WS_VCP) + kv * 64;
    const int nblk = 4 * cur + 3, ntc = (nblk + 63) >> 6;
    RESET_STATE();
    for (int rep_ = 0; rep_ < ((PROBE_REP >> 16) & 1) + 1; ++rep_) { RESET_STATE();
    stream_tiles_dma<DMA_SLOTS_C, false>(F, ntc, KC, VC, [&](int i) { return 64 * i; }, [&](int i, const LAS unsigned char* Kb, const LAS unsigned char* Vb) {
        const bool near = t0 - (1024 * i + 1039) < 128; const float bi = near ? 0.f : C.b31;
        f32x4 s[2][4]; qk64(Kb, C, qf, s, cinit(bi, m[0], true), cinit(bi, m[1], true), true, true);
        ab8 pf[2][2];
#pragma unroll
        for (int g = 0; g < 2; ++g) { if (near) mask_bias<true, false>(s[g], C, C.tq[g], 1024 * i + 31, 16, true);
            ref_step(s[g], m[g], O[g], L[g], pf[g], true); }
        pv64<false, true>(Vb, C, pf, O, L, true, true);
    });
    }
    float invl[2];
#pragma unroll
    for (int g = 0; g < 2; ++g) { const float lt = __shfl(L[g][0], C.n); invl[g] = lt > 0.f ? 1.0f / lt : 0.f; }
    stream_tiles_dma<DMA_SLOTS_C, true>(F, ntc, KC, VC, [&](int i) { return 64 * i; }, [&](int i, const LAS unsigned char* Kb, const LAS unsigned char* Vb) {
        const bool near = t0 - (1024 * i + 1039) < 128; const float bi = near ? 0.f : C.b31;
        f32x4 s[2][4]; qk64(Kb, C, qf, s, cinit(bi, m[0], true), cinit(bi, m[1], true), true, true);
        ab8 pf[2][2];
#pragma unroll
        for (int g = 0; g < 2; ++g) { if (near) mask_bias<true, false>(s[g], C, C.tq[g], 1024 * i + 31, 16, true);
#pragma unroll
            for (int kt = 0; kt < 4; ++kt) {
#pragma unroll
                for (int ii = 0; ii < 4; ++ii) s[g][kt][ii] = __builtin_amdgcn_exp2f(s[g][kt][ii]) * invl[g];
                float i0 = s[g][kt][0], i1 = s[g][kt][1], i2 = s[g][kt][2], i3 = s[g][kt][3];
                i0 += dpp_xor1(i0); i0 += dpp_xor2(i0); i1 += dpp_xor1(i1); i1 += dpp_xor2(i1); i2 += dpp_xor1(i2); i2 += dpp_xor2(i2); i3 += dpp_xor1(i3); i3 += dpp_xor2(i3);
                if (C.h == 0) { const int J = 16 * i + 4 * kt + C.q4; LAS float* sr = score + (8 * w + 4 * g + (C.n >> 2)) * SCS + J;
                    __hip_atomic_fetch_add(sr, 2.f * (i0 + i1 + i2) + i3, __ATOMIC_RELAXED, __HIP_MEMORY_SCOPE_WORKGROUP); __hip_atomic_fetch_add(sr + 1, i3, __ATOMIC_RELAXED, __HIP_MEMORY_SCOPE_WORKGROUP); } }
#pragma unroll
            for (int j = 0; j < 2; ++j) { v4u wv; wv.x = cvtpk(s[g][2 * j][0], s[g][2 * j][1]); wv.y = cvtpk(s[g][2 * j][2], s[g][2 * j][3]); wv.z = cvtpk(s[g][2 * j + 1][0], s[g][2 * j + 1][1]); wv.w = cvtpk(s[g][2 * j + 1][2], s[g][2 * j + 1][3]); pf[g][j] = __builtin_bit_cast(ab8, wv); } }
        pv64<true, false>(Vb, C, pf, O, L, true, true);
    });
#pragma unroll
    for (int g = 0; g < 2; ++g) { const float gsc = GA[(size_t)C.tq[g] * 24 + (kv * 4 + C.h) * 3 + 0];
#pragma unroll
        for (int dt = 0; dt < 4; ++dt) *(f32x4*)ACC_AT(g, dt) = O[g][dt] * gsc; }
    __syncthreads();
    for (int rep_ = 0; rep_ < ((PROBE_REP >> 19) & 1) + 1; ++rep_) select_queries<8>(score, cur, 8 * w, msk, lane);
    __syncthreads();
    if (w == 0) {
        int base = 0;
        for (int mm = 0; mm < 5; ++mm) { const int j = 64 * mm + lane; const bool has = (j <= cur) && ((msk[2 * (j < 258 ? j : 0)] | msk[2 * (j < 258 ? j : 0) + 1]) != 0u);
            const unsigned long long b = __ballot(has); const int pre = __popcll(b & ((1ull << lane) - 1ull));
            if (has) lst[1 + base + pre] = j; base += __popcll(b); }
        if (lane == 0) lst[0] = base;
    }
    __syncthreads();
    const int nbl = __builtin_amdgcn_readfirstlane(lst[0]);
    RESET_STATE();
    if (PROBE_REP & (1 << 20)) stream_tiles_multi<3>(F, nbl, wsp<bf16>(F, WS_KS) + kv * 64, wsp<bf16>(F, WS_VS) + kv * 64, [&](int i) { return 64 * lst[1 + i]; }, [&](int i, const LAS unsigned char* Kb, const LAS unsigned char* Vb) { (void)i; (void)Kb; (void)Vb; });
    for (int rep_ = 0; rep_ < ((PROBE_REP >> 18) & 1) + 1; ++rep_) { RESET_STATE();
    stream_stages_dma<3>(F, nbl, wsp<bf16>(F, WS_KS) + kv * 64, wsp<bf16>(F, WS_VS) + kv * 64, [&](int i) { return 64 * lst[1 + i]; }, [&](int i, const LAS unsigned char* Kb, const LAS unsigned char* Vb) {
        const int j = lst[1 + i]; const unsigned byte = (msk[2 * j + (w >> 2)] >> (8 * (w & 3))) & 0xffu;
        const bool a0 = (byte & 0xfu) != 0u, a1 = (byte & 0xf0u) != 0u;
        if (a0 || a1) {
            const bool near = j >= cur - 2; const float bi = near ? 0.f : C.b31;
            const bool c0 = ((byte >> (C.n >> 2)) & 1u) != 0u, c1 = ((byte >> (4 + (C.n >> 2))) & 1u) != 0u;
#define SEL_BODY(A0, A1) do { f32x4 s[2][4]; qk64(Kb, C, qf, s, cinit(bi, m[0], c0), cinit(bi, m[1], c1), A0, A1); ab8 pf[2][2]; \
                if (A0) { if (near) mask_bias<true, false>(s[0], C, C.tq[0], 64 * j, 1, true); ref_step(s[0], m[0], O[0], L[0], pf[0], c0); } \
                if (A1) { if (near) mask_bias<true, false>(s[1], C, C.tq[1], 64 * j, 1, true); ref_step(s[1], m[1], O[1], L[1], pf[1], c1); } \
                pv64<true, true>(Vb, C, pf, O, L, A0, A1); } while (0)
            if (a0 && a1) SEL_BODY(true, true); else if (a0) SEL_BODY(true, false); else SEL_BODY(false, true);
#undef SEL_BODY
        }
    });
    }
    FOLD_BRANCH(1);
    const int iw0 = (t0 >= 512) ? 0 : (512 - t0) >> 6;
    RESET_STATE();
    for (int rep_ = 0; rep_ < ((PROBE_REP >> 17) & 1) + 1; ++rep_) { RESET_STATE();
    stream_tiles_dma<DMA_SLOTS_W, true>(F, 9 - iw0, wsp<bf16>(F, WS_KW) + kv * 64, wsp<bf16>(F, WS_VW) + kv * 64, [&](int i) { return t0 - 512 + 64 * (i + iw0); }, [&](int i, const LAS unsigned char* Kb, const LAS unsigned char* Vb) {
        const int it = i + iw0, p0 = t0 - 512 + 64 * it; const bool near = it >= 6; const float bi = near ? 0.f : C.b31;
        f32x4 s[2][4]; qk64(Kb, C, qf, s, cinit(bi, m[0], true), cinit(bi, m[1], true), true, true);
        ab8 pf[2][2], vf[4][2]; pv_load(Vb, C, vf); __builtin_amdgcn_sched_barrier(0);
#pragma unroll
        for (int g = 0; g < 2; ++g) { if (near) mask_bias<true, false>(s[g], C, C.tq[g], p0, 1, true); else if (it == 0) mask_bias<false, true>(s[g], C, C.tq[g], p0, 1, true);
            ref_step(s[g], m[g], O[g], L[g], pf[g], true); }
        pv_mma(C, vf, pf, O, L, true, true);
    });
    }
    bf16* OA = wsp<bf16>(F, WS_OA);
#pragma unroll
    for (int g = 0; g < 2; ++g) { const float lt = __shfl(L[g][0], C.n); const float gsc = (lt > 0.f) ? GA[(size_t)C.tq[g] * 24 + (kv * 4 + C.h) * 3 + 2] / lt : 0.f;
#pragma unroll
        for (int dt = 0; dt < 4; ++dt) { const f32x4 o = *(const f32x4*)ACC_AT(g, dt) + O[g][dt] * gsc; v2u wv; wv.x = cvtpk(o[0], o[1]); wv.y = cvtpk(o[2], o[3]); *(v2u*)(OA + (size_t)C.tq[g] * 512 + (kv * 4 + C.h) * 64 + 16 * dt + 4 * C.q4) = wv; } }
#undef ACC_AT
#undef RESET_STATE
#undef FOLD_BRANCH
    __syncthreads();
}

constexpr int SU_V = 0;
constexpr int SU_COMB = 8 * TILEB;
constexpr int SU_SC = AT_END;
constexpr int SU_MSK = SU_SC + 4 * SCS * 4;
constexpr int SU_LST = SU_MSK + 2064;
constexpr int SU_SEL = SU_LST + 1056;
constexpr int SU_END = SU_SEL + 256;
static_assert(SU_COMB + 8 * 18 * 64 * 4 <= AT_LUT && SU_END <= RING_BYTES && SU_SC % 16 == 0, "sample unit LDS");

template <bool F32> DEV ab8 ld_kfrag(const char* rowp, int ks, int q4) {
    if (rowp == nullptr) return (ab8){0, 0, 0, 0, 0, 0, 0, 0};
    if (F32) { const f32x4 a = *(const f32x4*)(rowp + (32 * ks + 8 * q4) * 4), b = *(const f32x4*)(rowp + (32 * ks + 8 * q4) * 4 + 16);
        v4u w; w.x = cvtpk(a[0], a[1]); w.y = cvtpk(a[2], a[3]); w.z = cvtpk(b[0], b[1]); w.w = cvtpk(b[2], b[3]); return __builtin_bit_cast(ab8, w); }
    return *(const ab8*)(rowp + (32 * ks + 8 * q4) * 2);
}
template <class Src> DEV void qk64_src(const Src& S, const AttnCtx& C, const ab8 (&qf)[2][2], f32x4 (&s)[4], float init) {
    ab8 kf[4][2];
    int n_ = C.n, q4_ = C.q4; asm volatile("" : "+v"(n_), "+v"(q4_));
#pragma unroll
    for (int kt = 0; kt < 4; ++kt) { const char* rp = S.krow(16 * kt + n_); kf[kt][0] = ld_kfrag<Src::F32>(rp, 0, q4_); kf[kt][1] = ld_kfrag<Src::F32>(rp, 1, q4_); }
#pragma unroll
    for (int kt = 0; kt < 4; ++kt) { f32x4 c = {init, init, init, init}; c = __builtin_amdgcn_mfma_f32_16x16x32_bf16(kf[kt][0], qf[0][0], c, 0, 0, 0); s[kt] = __builtin_amdgcn_mfma_f32_16x16x32_bf16(kf[kt][1], qf[0][1], c, 0, 0, 0); }
}
template <class Src> DEV void stage_v(const Src& S, LAS unsigned char* Vb, int lane) {
    asm volatile("" : "+v"(lane) :: "memory");
    const char* rp = S.vrow(lane); LAS unsigned char* d = Vb + lane * TROW; const int sx = lane & 7;
    if (Src::F32) {
#pragma unroll
        for (int hh = 0; hh < 2; ++hh) {
            f32x4 v[8];
#pragma unroll
            for (int j = 0; j < 8; ++j) v[j] = rp ? *(const f32x4*)(rp + 128 * hh + 16 * j) : (f32x4){0.f, 0.f, 0.f, 0.f};
#pragma unroll
            for (int j = 0; j < 4; ++j) { v4u w; w.x = cvtpk(v[2 * j][0], v[2 * j][1]); w.y = cvtpk(v[2 * j][2], v[2 * j][3]); w.z = cvtpk(v[2 * j + 1][0], v[2 * j + 1][1]); w.w = cvtpk(v[2 * j + 1][2], v[2 * j + 1][3]); *(LAS v4u*)(d + (((4 * hh + j) ^ sx) << 4)) = w; }
            asm volatile("" ::: "memory");
        }
    } else {
        v4u v[8];
#pragma unroll
        for (int j = 0; j < 8; ++j) v[j] = rp ? *(const v4u*)(rp + 16 * j) : (v4u){0u, 0u, 0u, 0u};
#pragma unroll
        for (int j = 0; j < 8; ++j) *(LAS v4u*)(d + ((j ^ sx) << 4)) = v[j];
    }
    LDS_WAIT();
}
struct SCmpSrc { static constexpr bool F32 = false; const bf16 *K, *V; int blk0;
    DEV const char* krow(int kk) const { return (const char*)(K + (size_t)(blk0 + kk) * 128); }
    DEV const char* vrow(int kk) const { return (const char*)(V + (size_t)(blk0 + kk) * 128); } };
struct SSelSrc { static constexpr bool F32 = true; const float *K, *V, *Kn, *Vn; int j;
    DEV const char* krow(int kk) const { return j < 256 ? (const char*)(K + (size_t)kk * 128) : (kk < 4 ? (const char*)(Kn + kk * 128) : nullptr); }
    DEV const char* vrow(int kk) const { return j < 256 ? (const char*)(V + (size_t)kk * 128) : (kk < 4 ? (const char*)(Vn + kk * 128) : nullptr); } };
struct SWinSrc { static constexpr bool F32 = true; const float *K, *V; int nrows;
    DEV const char* krow(int kk) const { return kk < nrows ? (const char*)(K + (size_t)kk * 128) : nullptr; }
    DEV const char* vrow(int kk) const { return kk < nrows ? (const char*)(V + (size_t)kk * 128) : nullptr; } };

DEV void su_publish(LAS float* comb, int w, int lane, float m, float l, const f32x4 (&O)[4]) {
    LAS float* c = comb + w * 18 * 64 + lane; c[0] = m; c[64] = l;
#pragma unroll
    for (int dt = 0; dt < 4; ++dt)
#pragma unroll
        for (int i = 0; i < 4; ++i) c[(2 + 4 * dt + i) * 64] = O[dt][i];
}
DEV void su_combine(const LAS float* comb, int lane, float& l, f32x4 (&O)[4], bool withO) {
    float ms = NEG_INF;
#pragma unroll
    for (int w = 0; w < 8; ++w) ms = fmaxf(ms, comb[w * 18 * 64 + lane]);
    if (ms == NEG_INF) ms = 0.f;
    l = 0.f;
#pragma unroll
    for (int dt = 0; dt < 4; ++dt) O[dt] = (f32x4){0.f, 0.f, 0.f, 0.f};
#pragma unroll 1
    for (int w = 0; w < 8; ++w) { const LAS float* c = comb + w * 18 * 64 + lane; const float wg = __builtin_amdgcn_exp2f(c[0] - ms); l += c[64] * wg;
        if (withO) {
#pragma unroll
            for (int dt = 0; dt < 4; ++dt)
#pragma unroll
                for (int i = 0; i < 4; ++i) O[dt][i] += c[(2 + 4 * dt + i) * 64] * wg; } }
    l += __shfl_xor(l, 16); l += __shfl_xor(l, 32);
}

DEV void attn_unit_sample(Frame& F, int b, int kv) {
    int lane = F.lane; asm volatile("" : "+v"(lane));
    const int w = F.wave, tid = F.tid;
    AttnCtx C; C.n = lane & 15; C.q4 = lane >> 4; C.h = C.n & 3;
    C.lut = (const LAS float*)(F.lds + AT_LUT) + kv * 4 * 129;
    C.tq[0] = T + (C.n >> 2); C.tq[1] = C.tq[0];
    C.b31 = C.lut[C.h * 129 + 128];
    const int r = T + b * 4 + (C.n >> 2);
    LAS unsigned char* Vw = F.lds + SU_V + w * TILEB; LAS float* comb = (LAS float*)(F.lds + SU_COMB);
    LAS float* score = (LAS float*)(F.lds + SU_SC); LAS unsigned* msk = (LAS unsigned*)(F.lds + SU_MSK); LAS int* lst = (LAS int*)(F.lds + SU_LST);
    ab8 qf[2][2];
    { const bf16* QA = wsp<bf16>(F, WS_QA) + (size_t)r * 512 + (kv * 4 + C.h) * 64 + 8 * C.q4; qf[0][0] = *(const ab8*)QA; qf[0][1] = *(const ab8*)(QA + 32); qf[1][0] = qf[0][0]; qf[1][1] = qf[0][1]; }
    for (int i = tid; i < 4 * SCS; i += 512) score[i] = 0.f;
    for (int i = tid; i < 516; i += 512) msk[i] = 0u;
    const float* GA = wsp<float>(F, WS_GA) + (size_t)r * 24 + (kv * 4 + C.h) * 3;
    f32x4 OF[4], O[2][4], Ldum[2]; float m, l;
#pragma unroll
    for (int dt = 0; dt < 4; ++dt) OF[dt] = (f32x4){0.f, 0.f, 0.f, 0.f};
#define SU_RESET() do { m = NEG_INF; l = 0.f; _Pragma("unroll") for (int dt = 0; dt < 4; ++dt) O[0][dt] = (f32x4){0.f, 0.f, 0.f, 0.f}; } while (0)
    __syncthreads();
    const bf16* KC = wsp<bf16>(F, WS_KCS) + (size_t)b * 1024 * 128 + kv * 64; const bf16* VC = wsp<bf16>(F, WS_VCS) + (size_t)b * 1024 * 128 + kv * 64;
    SU_RESET();
#pragma unroll 1
    for (int ti = 2 * w; ti < 2 * w + 2; ++ti) {
        const bool near = ti == 15; SCmpSrc S{KC, VC, 64 * ti};
        f32x4 s[4]; qk64_src(S, C, qf, s, near ? 0.f : C.b31);
        if (near) mask_bias<true, false>(s, C, C.tq[0], 1024 * ti + 31, 16, true);
        const float mx = colmax16(s), mn = fmaxf(m, mx), ms = (mn == NEG_INF) ? 0.f : mn; float ps = 0.f;
#pragma unroll
        for (int kt = 0; kt < 4; ++kt)
#pragma unroll
            for (int ii = 0; ii < 4; ++ii) ps += __builtin_amdgcn_exp2f(s[kt][ii] - ms);
        l = l * __builtin_amdgcn_exp2f(m - ms) + ps; m = mn;
    }
    su_publish(comb, w, lane, m, l, O[0]);
    __syncthreads();
    float mfin = NEG_INF, invl;
    { f32x4 dummy[4]; float lt;
#pragma unroll
      for (int ww = 0; ww < 8; ++ww) mfin = fmaxf(mfin, comb[ww * 18 * 64 + lane]);
      su_combine(comb, lane, lt, dummy, false); invl = lt > 0.f ? 1.0f / lt : 0.f; if (mfin == NEG_INF) mfin = 0.f; }
    __syncthreads();
    SU_RESET();
#pragma unroll 1
    for (int ti = 2 * w; ti < 2 * w + 2; ++ti) {
        const bool near = ti == 15; SCmpSrc S{KC, VC, 64 * ti};
        f32x4 s[4]; qk64_src(S, C, qf, s, near ? 0.f : C.b31);
        if (near) mask_bias<true, false>(s, C, C.tq[0], 1024 * ti + 31, 16, true);
        stage_v(S, Vw, lane);
        ab8 pf[2][2];
#pragma unroll
        for (int kt = 0; kt < 4; ++kt) {
#pragma unroll
            for (int ii = 0; ii < 4; ++ii) s[kt][ii] = __builtin_amdgcn_exp2f(s[kt][ii] - mfin) * invl;
            float i0 = s[kt][0], i1 = s[kt][1], i2 = s[kt][2], i3 = s[kt][3];
            i0 += dpp_xor1(i0); i0 += dpp_xor2(i0); i1 += dpp_xor1(i1); i1 += dpp_xor2(i1); i2 += dpp_xor1(i2); i2 += dpp_xor2(i2); i3 += dpp_xor1(i3); i3 += dpp_xor2(i3);
            if (C.h == 0) { const int J = 16 * ti + 4 * kt + C.q4; LAS float* sr = score + (C.n >> 2) * SCS + J;
                __hip_atomic_fetch_add(sr, 2.f * (i0 + i1 + i2) + i3, __ATOMIC_RELAXED, __HIP_MEMORY_SCOPE_WORKGROUP); __hip_atomic_fetch_add(sr + 1, i3, __ATOMIC_RELAXED, __HIP_MEMORY_SCOPE_WORKGROUP); } }
#pragma unroll
        for (int j = 0; j < 2; ++j) { v4u wv; wv.x = cvtpk(s[2 * j][0], s[2 * j][1]); wv.y = cvtpk(s[2 * j][2], s[2 * j][3]); wv.z = cvtpk(s[2 * j + 1][0], s[2 * j + 1][1]); wv.w = cvtpk(s[2 * j + 1][2], s[2 * j + 1][3]); pf[0][j] = __builtin_bit_cast(ab8, wv); }
        pv64<true, false>(Vw, C, pf, O, Ldum, true, false);
    }
    su_publish(comb, w, lane, 0.f, 0.f, O[0]);
    __syncthreads();
    { float lt; f32x4 Oc[4]; su_combine(comb, lane, lt, Oc, true); const float g0 = GA[0];
#pragma unroll
      for (int dt = 0; dt < 4; ++dt) OF[dt] += Oc[dt] * g0; }
    if (w == 0) select_queries<4>(score, 256, 0, msk, lane);
    __syncthreads();
    if (w == 0) {
        int base = 0;
        for (int mm = 0; mm < 5; ++mm) { const int j = 64 * mm + lane; const bool has = (j <= 256) && (msk[2 * (j < 258 ? j : 0)] != 0u);
            const unsigned long long bb = __ballot(has); const int pre = __popcll(bb & ((1ull << lane) - 1ull));
            if (has) lst[1 + base + pre] = j; base += __popcll(bb); }
        if (lane == 0) lst[0] = base;
    }
    __syncthreads();
    const int nbl = lst[0];
    const int* pt = ((const int*)F.A.in[9]) + b * 128;
    SU_RESET();
#pragma unroll 1
    for (int idx = w; idx < nbl; idx += 8) {
        const int j = lst[1 + idx]; const unsigned nib = msk[2 * j] & 0xfu;
        const size_t pg = (j < 256) ? ((size_t)pt[j >> 1] * 16384 + (size_t)((j & 1) * 64) * 128) : 0;
        SSelSrc S{((const float*)F.A.in[4]) + pg + kv * 64, ((const float*)F.A.in[5]) + pg + kv * 64, F.out + O_SKS + (size_t)b * 4 * 128 + kv * 64, F.out + O_SVS + (size_t)b * 4 * 128 + kv * 64, j};
        const bool near = j >= 254; const bool colok = ((nib >> (C.n >> 2)) & 1u) != 0u;
        f32x4 s[4]; qk64_src(S, C, qf, s, near ? 0.f : C.b31);
        if (near) mask_bias<true, false>(s, C, C.tq[0], 64 * j, 1, colok); else mask_bias<false, false>(s, C, C.tq[0], 64 * j, 1, colok);
        stage_v(S, Vw, lane);
        ab8 pf[2][2]; online_step(s, m, l, O[0], pf[0]);
        pv64<true, false>(Vw, C, pf, O, Ldum, true, false);
    }
    su_publish(comb, w, lane, m, l, O[0]);
    __syncthreads();
    { float lt; f32x4 Os[4]; su_combine(comb, lane, lt, Os, true); const float g1 = lt > 0.f ? GA[1] / lt : 0.f;
#pragma unroll
      for (int dt = 0; dt < 4; ++dt) OF[dt] += Os[dt] * g1; }
    __syncthreads();
    SU_RESET();
#pragma unroll 1
    for (int ti = w; ti < 9; ti += 8) {
        const bool nw = ti == 8;
        SWinSrc S{nw ? F.out + O_SKW + (size_t)(b * 512 + 508) * 128 + kv * 64 : ((const float*)F.A.in[6]) + (size_t)(b * 512 + 64 * ti) * 128 + kv * 64,
                  nw ? F.out + O_SVW + (size_t)(b * 512 + 508) * 128 + kv * 64 : ((const float*)F.A.in[7]) + (size_t)(b * 512 + 64 * ti) * 128 + kv * 64, nw ? 4 : 64};
        const bool near = ti >= 6; const int p0 = T - 512 + 64 * ti;
        f32x4 s[4]; qk64_src(S, C, qf, s, near ? 0.f : C.b31);
        if (near) mask_bias<true, false>(s, C, C.tq[0], p0, 1, true); else if (ti == 0) mask_bias<false, true>(s, C, C.tq[0], p0, 1, true);
        stage_v(S, Vw, lane);
        ab8 pf[2][2]; online_step(s, m, l, O[0], pf[0]);
        pv64<true, false>(Vw, C, pf, O, Ldum, true, false);
    }
    su_publish(comb, w, lane, m, l, O[0]);
    __syncthreads();
    if (w == 0) { float lt; f32x4 Ow[4]; su_combine(comb, lane, lt, Ow, true); const float g2 = lt > 0.f ? GA[2] / lt : 0.f;
        bf16* OA = wsp<bf16>(F, WS_OA) + (size_t)r * 512 + (kv * 4 + C.h) * 64 + 4 * C.q4;
#pragma unroll
        for (int dt = 0; dt < 4; ++dt) { const f32x4 o = OF[dt] + Ow[dt] * g2; v2u wv; wv.x = cvtpk(o[0], o[1]); wv.y = cvtpk(o[2], o[3]); *(v2u*)(OA + 16 * dt) = wv; } }
#undef SU_RESET
    __syncthreads();
}
DEV void hgrn_c_unit(Frame& F, int c, int hp);
DEV void p3_phase(Frame& F, bool do_scan, int qoff) {
    { const float* TB = wsp<float>(F, WS_TBL) + TB_BIAS; LAS float* biasL = (LAS float*)(F.lds + LDSBIAS_OFF); LAS float* lut2 = (LAS float*)(F.lds + AT_LUT);
      for (int i = F.tid; i < 8 * 129; i += 512) { const float b = TB[i]; biasL[i] = b; lut2[i] = b * LOG2E; } }
    __syncthreads();
    unsigned* scan_done = (unsigned*)(F.ws + WS_CTL) + CTL_Q + 384;
    if (do_scan) { hgrn_scan(F);
        if (F.vcu < 64) { asm volatile("s_waitcnt vmcnt(0)" ::: "memory"); __syncthreads(); if (F.tid == 0) { __builtin_amdgcn_fence(__ATOMIC_RELEASE, "agent"); (void)xb_add(scan_done, 1u); } } }
    {
        LAS int* qslot = (LAS int*)(F.lds + LDSCTL_OFF + 32); unsigned* qctr = (unsigned*)(F.ws + WS_CTL) + CTL_Q + qoff;
        const int k0 = (int)(xb_xcc_id() & 1u);
        for (int pass = 0; pass < 2; ++pass) { const int kq = k0 ^ pass;
            for (;;) {
                if (F.tid == 0) *qslot = (int)atomicAdd(qctr + 64 * kq, 1u);
                __syncthreads();
                const int item = *qslot;
                __syncthreads();
                if (item >= 288) break;
                if (item < 32) attn_unit_sample(F, item, kq); else attn_unit_mfma(F, 255 - (item - 32), kq);
            }
        }
    }
    {
        LAS int* qslot = (LAS int*)(F.lds + LDSCTL_OFF + 32); unsigned* hctr = (unsigned*)(F.ws + WS_CTL) + CTL_Q + 320 + (qoff ? 32 : 0);
        for (;;) {
            if (F.tid == 0) *qslot = (int)atomicAdd(hctr, 1u);
            __syncthreads();
            const int item = *qslot;
            __syncthreads();
            if (item >= 128) break;
            hgrn_sample_unit(F, item >> 2, item & 3);
        }
    }
    {
        LAS int* qslot = (LAS int*)(F.lds + LDSCTL_OFF + 32); unsigned* cctr = (unsigned*)(F.ws + WS_CTL) + CTL_Q + 448 + (qoff ? 32 : 0);
        bool ready = false;
        for (;;) {
            if (F.tid == 0) *qslot = (int)atomicAdd(cctr, 1u);
            __syncthreads();
            const int item = *qslot;
            __syncthreads();
            if (item >= 512) break;
            if (!ready) {
                if (F.tid == 0) { unsigned sp = 0u; while (xb_ld(scan_done) < 64u) { __builtin_amdgcn_s_sleep(2); if (++sp > (1u << 22)) break; }
                    __builtin_amdgcn_fence(__ATOMIC_ACQUIRE, "agent"); asm volatile("s_waitcnt vmcnt(0)" ::: "memory"); }
                __syncthreads(); ready = true;
            }
            hgrn_c_unit(F, item >> 1, item & 1);
        }
    }
    if (PROBE_REP & 4096) for (int u = F.vcu; u < 512; u += F.G) { const int qg = u < 256 ? u : 511 - u, kv = u < 256 ? 0 : 1; attn_unit_mfma(F, qg, kv); }
    __syncthreads();
    if (PROBE_REP & 8192) for (int u = F.vcu; u < 2 * DEC_B; u += F.G) attn_unit_sample(F, u >> 1, u & 1);
    __syncthreads();
}

constexpr int HC_SROW = 288;
DEV void hgrn_c_unit(Frame& F, int c, int hp) {
    LAS unsigned char* L = F.lds;
    const int tid = F.tid, w = F.wave, lane = F.lane, n = lane & 15, q4 = lane >> 4;
    { const bf16* HL = wsp<bf16>(F, WS_HL) + (size_t)(c * 4 + 2 * hp) * 16384;
#pragma unroll
      for (int j = 0; j < 8; ++j) { const int e8 = tid + 512 * j; const v4u v = *(const v4u*)(HL + 8 * e8); const int hh = e8 >> 11, rem = e8 & 2047, kr = rem >> 4, vc = (rem & 15) * 8;
          *(LAS v4u*)(L + hh * 128 * HC_SROW + kr * HC_SROW + 2 * vc) = v; } }
    __syncthreads();
    const int h = 2 * hp + (w >> 2), ti = w & 3; const size_t row = (size_t)c * 64 + 16 * ti + n;
    const LAS unsigned char* Sb = L + (w >> 2) * 128 * HC_SROW;
    const bf16* qp = wsp<bf16>(F, WS_HQT) + row * 512 + h * 128 + 8 * q4;
    f32x4 acc[8];
#pragma unroll
    for (int vt = 0; vt < 8; ++vt) acc[vt] = *(const f32x4*)(wsp<float>(F, WS_HIN) + row * 512 + h * 128 + 16 * vt + 4 * q4);
#pragma unroll
    for (int ks = 0; ks < 4; ++ks) { const ab8 qf = *(const ab8*)(qp + 32 * ks);
#pragma unroll
        for (int vt = 0; vt < 8; ++vt) { const ab8 sf = tr_frag(Sb, 32 * ks, 32 * vt, n, q4, HC_SROW); acc[vt] = __builtin_amdgcn_mfma_f32_16x16x32_bf16(sf, qf, acc[vt], 0, 0, 0); } }
    float ss = 0.f;
#pragma unroll
    for (int vt = 0; vt < 8; ++vt) ss += (acc[vt][0] * acc[vt][0] + acc[vt][1] * acc[vt][1]) + (acc[vt][2] * acc[vt][2] + acc[vt][3] * acc[vt][3]);
    ss += __shfl_xor(ss, 16); ss += __shfl_xor(ss, 32);
    const float rr = 1.0f / sqrtf(ss * (1.f / 128.f) + EPS);
    const bf16* HG = wsp<bf16>(F, WS_HG) + row * 512 + h * 128 + 4 * q4; bf16* OB = wsp<bf16>(F, WS_OB) + row * 512 + h * 128 + 4 * q4; const float* gn = ((const float*)F.A.in[20]) + 4 * q4;
#pragma unroll
    for (int vt = 0; vt < 8; ++vt) { const v2u gw_ = *(const v2u*)(HG + 16 * vt); const f32x4 g4 = *(const f32x4*)(gn + 16 * vt);
        v2u wv; wv.x = cvtpk(acc[vt][0] * rr * g4[0] * bflo(gw_.x), acc[vt][1] * rr * g4[1] * bfhi(gw_.x)); wv.y = cvtpk(acc[vt][2] * rr * g4[2] * bflo(gw_.y), acc[vt][3] * rr * g4[3] * bfhi(gw_.y));
        *(v2u*)(OB + 16 * vt) = wv; }
    __syncthreads();
}
DEV void p4_phase(Frame& F) {
    const float* HO = wsp<float>(F, WS_HO);
    for (int it = F.vcu * 8 + F.wave; it < NSMP * 4; it += F.G * 8) { const int rs = it >> 2, h = it & 3; const size_t g = (size_t)rs * 512 + h * 128 + 2 * F.lane;
        const f32x2 o = *(const f32x2*)(HO + g); const float ss = wave_sum(o.x * o.x + o.y * o.y); const float rr = 1.0f / sqrtf(ss * (1.f / 128.f) + EPS);
        const size_t go = (size_t)(T + rs) * 512 + h * 128 + 2 * F.lane; const unsigned gw_ = *(const unsigned*)(wsp<bf16>(F, WS_HG) + go);
        *(unsigned*)(wsp<bf16>(F, WS_OB) + go) = pk2(o.x * rr * ((const float*)F.A.in[20])[2 * F.lane] * bflo(gw_), o.y * rr * ((const float*)F.A.in[20])[2 * F.lane + 1] * bfhi(gw_)); }
}

constexpr int NPHASE = 12;

__global__ void __launch_bounds__(512, 2) mk_fwd(Args args) {
    extern __shared__ __attribute__((aligned(16))) unsigned char lds[];
    Frame F{args};
    F.lds = (LAS unsigned char*)lds; F.tid = threadIdx.x; F.lane = F.tid & 63; F.wave = __builtin_amdgcn_readfirstlane(F.tid >> 6);
    F.G = gridDim.x; { const int bx = blockIdx.x; F.vcu = (F.G % 8 == 0) ? (bx % 8) * (F.G / 8) + bx / 8 : bx; }
    F.out = args.out; F.ws = args.ws;
    for (int u = F.tid; u < 16; u += 512) ((LAS unsigned*)(F.lds + LDSCTL_OFF))[u] = 0u;
    __syncthreads();
    const int lo = args.ph_lo, hi = args.ph_hi;
    XcdBarrier bar; bar.bar = (unsigned*)(F.ws + WS_CTL) + 4096; bar.x = 0; bar.st = (volatile LAS unsigned*)(F.lds + LDSCTL_OFF);
    if (hi - lo > 1) bar = xcd_barrier_post((unsigned*)(F.ws + WS_CTL) + 4096, (volatile LAS unsigned*)(F.lds + LDSCTL_OFF));
#define IN(k) (lo <= (k) && (k) < hi)
#define PHASE_BEGIN() do { int t_ = threadIdx.x; asm volatile("" : "+v"(t_)); F.tid = t_; F.lane = t_ & 63; F.wave = __builtin_amdgcn_readfirstlane(t_ >> 6); } while (0)
#define SEAM(k) do { if (IN(k) && IN((k) + 1)) xcd_barrier(bar); } while (0)
    const int cid = (int)blockIdx.x;

    if (IN(0)) { PHASE_BEGIN(); p0_prologue(F, true); if (PROBE_REP & 1) { __syncthreads(); p0_prologue(F, false); } } SEAM(0);
    if (IN(1)) {
        SchedOne S{(const char*)(F.ws + WS_XN), (const char*)(F.ws + WS_WIN), MP / 256, NIN / 256, 1024, F.G, cid};
        EpiP1 E{F.out, wsp<bf16>(F, WS_QA), wsp<bf16>(F, WS_KS), wsp<bf16>(F, WS_VS), wsp<bf16>(F, WS_KW), wsp<bf16>(F, WS_VW), wsp<bf16>(F, WS_CKP), wsp<bf16>(F, WS_CVP), wsp<bf16>(F, WS_HQ), wsp<bf16>(F, WS_HI),
                wsp<bf16>(F, WS_HG), wsp<bf16>(F, WS_SGA), wsp<bf16>(F, WS_SGB), wsp<bf16>(F, WS_TK), wsp<bf16>(F, WS_TV), wsp<float>(F, WS_HF), wsp<float>(F, WS_GA)};
        pg8::gemm_phase<EpiP1, SchedOne, true, true>(F.lds, 1024, S, E);
        if (PROBE_REP & (1 << 1)) {pg8::gemm_phase<EpiP1, SchedOne, true, true>(F.lds, 1024, S, E); }
        PHASE_BEGIN();
        { LAS float* scr = (LAS float*)(F.lds + F.wave * 16384);
          const int rem = P1_U0 % F.G, first = rem ? rem : 0, nw = (F.G - first) * 8;
          if (cid >= first) for (int d = (cid - first) * 8 + F.wave; d < DEF_N; d += nw) { if (d < DEF_NTR) tr_dispatch(F, DEF_I0 + d, scr, F.lane); else win_copy_item(F, d - DEF_NTR, F.lane); }
          __syncthreads(); }
        for (int rep = 0; rep < ((PROBE_REP >> 14) & 1) + 1; ++rep)
        for (int u = F.G - 1 - F.vcu; u < 512; u += F.G) cmp_gemm_unit(F, u >> 8, u & 255);
    } SEAM(1);
    if (IN(2)) { PHASE_BEGIN(); p2_phase(F); if (PROBE_REP & 4) { __syncthreads(); p2_phase(F); } } SEAM(2);
    if (IN(3)) { PHASE_BEGIN(); p3_phase(F, true, 0); if (PROBE_REP & 8) { __syncthreads(); p3_phase(F, false, 128); } } SEAM(3);
    if (IN(5)) {
        SchedOne S{(const char*)(F.ws + WS_OA), (const char*)(F.ws + WS_WPA), T / 256, 4, 512, F.G, cid};
        EpiProjA E{wsp<bf16>(F, WS_SGA), wsp<float>(F, WS_PT)};
        PHASE_BEGIN(); small_gemm<512>(F, wsp<bf16>(F, WS_OA), wsp<bf16>(F, WS_WPA), E);
        pg8::gemm_phase<EpiProjA, SchedOne, true, true>(F.lds, 512, S, E);
        if (PROBE_REP & (1 << 5)) {pg8::gemm_phase<EpiProjA, SchedOne, true, true>(F.lds, 512, S, E); }
    } if (IN(5) && IN(6)) { asm volatile("s_waitcnt vmcnt(0)" ::: "memory"); __syncthreads(); }
    if (IN(6)) {
        SchedOne S{(const char*)(F.ws + WS_OB), (const char*)(F.ws + WS_WPB), T / 256, 4, 512, F.G, cid};
        EpiProjB E{wsp<bf16>(F, WS_SGB), wsp<float>(F, WS_PT), wsp<bf16>(F, WS_MG)};
        PHASE_BEGIN(); small_gemm<512>(F, wsp<bf16>(F, WS_OB), wsp<bf16>(F, WS_WPB), E);
        pg8::gemm_phase<EpiProjB, SchedOne, true, true>(F.lds, 512, S, E);
        if (PROBE_REP & (1 << 6)) {pg8::gemm_phase<EpiProjB, SchedOne, true, true>(F.lds, 512, S, E); }
    } SEAM(6);
    if (IN(7)) {
        SchedOne S{(const char*)(F.ws + WS_MG), (const char*)(F.ws + WS_WO), T / 256, 4, 1024, F.G, cid};
        EpiResid E{((const float*)F.A.in[0]), ((const float*)F.A.in[1]), wsp<float>(F, WS_X1)};
        PHASE_BEGIN(); small_gemm<1024>(F, wsp<bf16>(F, WS_MG), wsp<bf16>(F, WS_WO), E);
        pg8::gemm_phase<EpiResid, SchedOne, true, true>(F.lds, 1024, S, E);
        if (PROBE_REP & (1 << 7)) {pg8::gemm_phase<EpiResid, SchedOne, true, true>(F.lds, 1024, S, E); }
    } SEAM(7);
    if (IN(8)) { PHASE_BEGIN();
        const int gw = F.vcu * 8 + F.wave, NGW = F.G * 8;
        for (int rep = 0; rep < ((PROBE_REP >> 8) & 1) + 1; ++rep)
        { const float* X1 = wsp<float>(F, WS_X1); bf16* XN = wsp<bf16>(F, WS_XN); rms_rows<false>(gw, NGW, MR, [&](int m) { return X1 + (size_t)m * DM; }, [&](int m) { return XN + (size_t)m * DM; }, ((const float*)F.A.in[24]), F.lane); }
    } SEAM(8);
    if (IN(9)) {
        SchedOne S{(const char*)(F.ws + WS_XN), (const char*)(F.ws + WS_WGU), MP / 256, NGU / 256, 1024, F.G, cid};
        EpiFfUp E{wsp<bf16>(F, WS_FF)};
        pg8::gemm_phase<EpiFfUp, SchedOne, true, true>(F.lds, 1024, S, E);
        if (PROBE_REP & (1 << 9)) {pg8::gemm_phase<EpiFfUp, SchedOne, true, true>(F.lds, 1024, S, E); }
    } SEAM(9);
    if (IN(10)) {
        SchedOne S{(const char*)(F.ws + WS_FF), (const char*)(F.ws + WS_WD), T / 256, 4, DFF, F.G, cid};
        EpiResid Es{wsp<float>(F, WS_X1), nullptr, wsp<float>(F, WS_PT)};
        PHASE_BEGIN(); small_gemm<DFF>(F, wsp<bf16>(F, WS_FF), wsp<bf16>(F, WS_WD), Es);
        {
          LAS int* qslot = (LAS int*)(F.lds + LDSCTL_OFF + 32); unsigned* scnt = (unsigned*)(F.ws + WS_CTL) + CTL_PC + 4096;
          const int mine = F.vcu < 256 ? (256 - F.vcu + F.G - 1) / F.G : 0;
          asm volatile("s_waitcnt vmcnt(0)" ::: "memory"); __syncthreads();
          if (F.tid == 0) { __builtin_amdgcn_fence(__ATOMIC_RELEASE, "agent"); const unsigned old = xb_add(scnt, (unsigned)mine); const bool last = mine > 0 && old + (unsigned)mine == 256u;
              if (last) { __builtin_amdgcn_fence(__ATOMIC_ACQUIRE, "agent"); asm volatile("s_waitcnt vmcnt(0)" ::: "memory"); } *qslot = last ? 1 : 0; }
          __syncthreads();
          if (*qslot) { const float* X2 = wsp<float>(F, WS_PT); float* Y = F.out; rms_rows<true>(T + 16 * F.wave, 1, T + 16 * F.wave + 16, [&](int m) { return X2 + (size_t)m * DM; }, [&](int m) { return Y + (size_t)m * DM; }, ((const float*)F.A.in[28]), F.lane); }
          __syncthreads(); }
        EpiFinal E{wsp<float>(F, WS_X1), F.out, ((const float*)F.A.in[28]), (float*)(F.ws + WS_XS), (unsigned*)(F.ws + WS_CTL) + CTL_PC};
        pg8::gemm_phase<EpiFinal, SchedOne, true, true>(F.lds, DFF, S, E);
    }
#undef IN
#undef SEAM
}

#ifndef MK_SPLIT
#define MK_SPLIT 0
#endif
extern "C" void kernel_launch(void* const* d_in, const int* in_sizes, int n_in, void* d_out, int out_size, void* d_ws, size_t ws_size, hipStream_t stream) {
    static int grid = 0;
    if (grid == 0) {
        if (n_in != 29 || out_size != (int)O_END || ws_size < WS_END) { fprintf(stderr, "kernel_launch: unexpected shapes: n_in %d out %d ws %zu (need %zu)\n", n_in, out_size, ws_size, (size_t)WS_END); grid = -1; return; }
        int dev = 0, cus = 0, per_cu = 0;
        if (hipGetDevice(&dev) != hipSuccess || hipDeviceGetAttribute(&cus, hipDeviceAttributeMultiprocessorCount, dev) != hipSuccess) { grid = -1; return; }
        if (hipFuncSetAttribute((const void*)mk_fwd, hipFuncAttributeMaxDynamicSharedMemorySize, LDS_BYTES) != hipSuccess) { fprintf(stderr, "kernel_launch: hipFuncSetAttribute failed\n"); grid = -1; return; }
        if (hipOccupancyMaxActiveBlocksPerMultiprocessor(&per_cu, (const void*)mk_fwd, 512, LDS_BYTES) != hipSuccess || per_cu < 1) fprintf(stderr, "kernel_launch: occupancy query reports %d\n", per_cu);
        (void)hipGetLastError();
        grid = cus;
    }
    if (grid < 0) return;
    (void)hipMemsetAsync((char*)d_ws + WS_CTL, 0, CTL_ZERO_BYTES, stream);
    Args a{};
    for (int i = 0; i < 29; ++i) a.in[i] = d_in[i];
    a.out = (float*)d_out; a.ws = (unsigned char*)d_ws;
#if MK_SPLIT
    for (int p = 0; p < NPHASE; ++p) { a.ph_lo = p; a.ph_hi = p + 1; hipLaunchKernelGGL(mk_fwd, dim3(grid), dim3(512), LDS_BYTES, stream, a); }
#else
    a.ph_lo = 0; a.ph_hi = NPHASE; hipLaunchKernelGGL(mk_fwd, dim3(grid), dim3(512), LDS_BYTES, stream, a);
#endif
    const hipError_t le = hipPeekAtLastError();
    if (le != hipSuccess) fprintf(stderr, "kernel_launch: launch failed: %s\n", hipGetErrorName(le));
}
```

```cpp
#include <hip/hip_runtime.h>
#include <cstdio>
#include <cstdint>
namespace pg8 {
#define PG8_LAS __attribute__((address_space(3)))
typedef unsigned short bf16_t;
typedef short bf16x8 __attribute__((ext_vector_type(8)));
typedef float f32x4 __attribute__((ext_vector_type(4)));
typedef unsigned u32x4 __attribute__((ext_vector_type(4)));
constexpr int BM = 256, BK = 64, HALF = 128, HTB = HALF * BK * 2  , STAGE_BYTES = 8 * HTB, NXCD = 8, WGM = 8;

__host__ __device__ __forceinline__ int lds_byte(int r, int c) { const int st = (r >> 4) * 2 + (c >> 5), rr = r & 15, cc = c & 31, ob = rr * 64 + cc * 2; return st * 1024 + (ob ^ (((ob >> 9) & 1) << 5)); }
__host__ __device__ __forceinline__ void stage_rc(int b, int& R, int& C) { const int st = b / 1024, sb = b % 1024, swz = sb ^ (((sb >> 9) & 1) << 5); R = (st >> 1) * 16 + swz / 64; C = (st & 1) * 32 + (swz % 64) / 2; }
__host__ __device__ __forceinline__ int perm32(int rho) { const int n = rho >> 4, i = rho & 15; return 8 * (i >> 2) + 4 * n + (i & 3); }

struct Unit { int pm, pn, gi; };

__device__ __forceinline__ unsigned cvt_pk_bf16(float lo, float hi) { typedef float f2_ __attribute__((ext_vector_type(2))); typedef __bf16 b2_ __attribute__((ext_vector_type(2))); f2_ v = {lo, hi}; b2_ b = __builtin_convertvector(v, b2_); return __builtin_bit_cast(unsigned, b); }

template <class Epi, class Sched, bool ALIGN_EPI = false, bool SP2 = false>
__device__ __forceinline__ void gemm_phase(PG8_LAS unsigned char* lds, const int Kdim, const Sched& S, const Epi& E) {
    int tid_ = threadIdx.x; asm volatile("" : "+v"(tid_));
    const int tid = tid_, wid = __builtin_amdgcn_readfirstlane(tid >> 6), lane = tid & 63, wr = wid >> 2, wc = wid & 3, fr = lane & 15, fq = lane >> 4;
    const int K = Kdim, nt = K / BK;
    unsigned voffA[2], voffB[2];
#pragma unroll
    for (int i = 0; i < 2; ++i) { int R, C; stage_rc(tid * 16 + i * 8192, R, C); const int Rb = Epi::PERM ? ((R & ~31) + perm32(R & 31)) : R;
        voffA[i] = (unsigned)(R * K + C) * 2u; voffB[i] = (unsigned)(Rb * K + C) * 2u; }
    const size_t kstep = (size_t)(BK * 2);
    const size_t hstep = (size_t)HALF * K * 2;
    const unsigned ldsw = (unsigned)wid * 1024u;
    const int aoff = lds_byte(wr * 64 + fr, fq * 8), boff = lds_byte(wc * 32 + fr, fq * 8);
#define PG8_SA(b, h) (((b) * 2 + (h)) * HTB)
#define PG8_SB(b, h) ((4 + (b) * 2 + (h)) * HTB)
#define PG8_STAGE(bufoff, gbase, voff) do { _Pragma("unroll") for (int _i = 0; _i < 2; ++_i) \
        __builtin_amdgcn_global_load_lds((const unsigned*)((const char*)(gbase) + (voff)[_i]), (PG8_LAS unsigned*)(lds + (bufoff) + ldsw + _i * 8192), 16, 0, 0); } while (0)
#define PG8_LDA(dst, b, h) do { _Pragma("unroll") for (int m = 0; m < 4; ++m) _Pragma("unroll") for (int k = 0; k < 2; ++k) dst[m][k] = *(const PG8_LAS bf16x8*)(lds + PG8_SA(b, h) + aoff + m * 2048 + k * 1024); } while (0)
#define PG8_LDB(dst, b, h) do { _Pragma("unroll") for (int n = 0; n < 2; ++n) _Pragma("unroll") for (int k = 0; k < 2; ++k) dst[n][k] = *(const PG8_LAS bf16x8*)(lds + PG8_SB(b, h) + boff + n * 2048 + k * 1024); } while (0)
#define PG8_MMA(ai, bj, At, Bt) do { __builtin_amdgcn_s_setprio(1); _Pragma("unroll") for (int m = 0; m < 4; ++m) _Pragma("unroll") for (int n = 0; n < 2; ++n) _Pragma("unroll") for (int k = 0; k < 2; ++k) \
        acc[ai][bj][m][n] = __builtin_amdgcn_mfma_f32_16x16x32_bf16(Bt[n][k], At[m][k], acc[ai][bj][m][n], 0, 0, 0); __builtin_amdgcn_s_setprio(0); } while (0)
#define PG8_WAIT_V(n) asm volatile("s_waitcnt vmcnt(" #n ")" ::: "memory")
#define PG8_WAIT_L(n) asm volatile("s_waitcnt lgkmcnt(" #n ")" ::: "memory")
#define PG8_BAR __builtin_amdgcn_s_barrier()
#define PG8_SCHED __builtin_amdgcn_sched_barrier(0)
    Unit cur, nxt; int ui = 0;
    if (!S.next(0, cur)) return;
    f32x4 acc[2][2][4][2];
#pragma unroll
    for (int a = 0; a < 2; ++a)
#pragma unroll
        for (int b = 0; b < 2; ++b)
#pragma unroll
            for (int m = 0; m < 4; ++m)
#pragma unroll
                for (int n = 0; n < 2; ++n) acc[a][b][m][n] = (f32x4){0.f, 0.f, 0.f, 0.f};
    bf16x8 At[4][2], B0[2][2], B1[2][2];
    const char* cA; const char* cB; S.ptrs(cur, cA, cB);
    S.a_ready(cur);
    if constexpr (SP2) {
        PG8_STAGE(PG8_SB(0, 0), cB, voffB); PG8_STAGE(PG8_SB(0, 1), cB + hstep, voffB); PG8_STAGE(PG8_SA(0, 0), cA, voffA); PG8_STAGE(PG8_SA(0, 1), cA + hstep, voffA);
        if (wr == 1) PG8_BAR;
        PG8_WAIT_V(2); PG8_BAR;
        PG8_STAGE(PG8_SB(1, 0), cB + kstep, voffB); PG8_STAGE(PG8_SA(1, 0), cA + kstep, voffA); PG8_STAGE(PG8_SB(1, 1), cB + hstep + kstep, voffB);
        PG8_WAIT_V(6); PG8_BAR;
    } else {
        PG8_STAGE(PG8_SB(0, 0), cB, voffB); PG8_STAGE(PG8_SA(0, 0), cA, voffA); PG8_STAGE(PG8_SB(0, 1), cB + hstep, voffB); PG8_STAGE(PG8_SA(0, 1), cA + hstep, voffA);
        if (wr == 1) PG8_BAR;
        PG8_WAIT_V(4); PG8_BAR;
        PG8_STAGE(PG8_SB(1, 0), cB + kstep, voffB); PG8_STAGE(PG8_SA(1, 0), cA + kstep, voffA); PG8_STAGE(PG8_SB(1, 1), cB + hstep + kstep, voffB);
        PG8_WAIT_V(6); PG8_BAR;
    }
    for (;;) {
        const bool has_next = S.next(ui + 1, nxt);
        const char* nA = cA; const char* nB = cB; if (has_next) S.ptrs(nxt, nA, nB);
        for (int t = 0; t < nt; t += 2) {
            const bool last = (t == nt - 2);
            const char* a1 = cA + (size_t)(t + 1) * kstep;
            const char* a2 = last ? nA : cA + (size_t)(t + 2) * kstep; const char* b2 = last ? nB : cB + (size_t)(t + 2) * kstep;
            const char* a3 = a2 + kstep; const char* b3 = b2 + kstep;
            if (last && has_next) S.a_ready(nxt);
            if constexpr (SP2) {
            PG8_LDB(B0, 0, 0); PG8_LDB(B1, 0, 1); PG8_SCHED; PG8_LDA(At, 0, 0); PG8_STAGE(PG8_SA(1, 1), a1 + hstep, voffA);
            PG8_WAIT_V(8); PG8_WAIT_L(0); PG8_BAR; PG8_MMA(0, 0, At, B0); PG8_MMA(0, 1, At, B1); PG8_BAR; PG8_SCHED;
            PG8_LDA(At, 0, 1); PG8_STAGE(PG8_SB(0, 0), b2, voffB); PG8_STAGE(PG8_SB(0, 1), b2 + hstep, voffB); PG8_STAGE(PG8_SA(0, 0), a2, voffA);
            PG8_WAIT_V(8); PG8_WAIT_L(0); PG8_BAR; PG8_MMA(1, 0, At, B0); PG8_MMA(1, 1, At, B1); PG8_BAR; PG8_SCHED;
            PG8_LDB(B0, 1, 0); PG8_LDB(B1, 1, 1); PG8_SCHED; PG8_LDA(At, 1, 0); PG8_STAGE(PG8_SA(0, 1), a2 + hstep, voffA);
            PG8_WAIT_V(8); PG8_WAIT_L(0); PG8_BAR; PG8_MMA(0, 0, At, B0); PG8_MMA(0, 1, At, B1); PG8_BAR; PG8_SCHED;
            PG8_LDA(At, 1, 1); PG8_STAGE(PG8_SB(1, 0), b3, voffB); PG8_STAGE(PG8_SB(1, 1), b3 + hstep, voffB); PG8_STAGE(PG8_SA(1, 0), a3, voffA);
            PG8_WAIT_V(8); PG8_WAIT_L(0); PG8_BAR; PG8_MMA(1, 0, At, B0); PG8_MMA(1, 1, At, B1); PG8_BAR; PG8_SCHED;
            } else {
            PG8_LDB(B0, 0, 0); PG8_SCHED; PG8_LDA(At, 0, 0); PG8_STAGE(PG8_SA(1, 1), a1 + hstep, voffA);
            PG8_WAIT_L(8); PG8_BAR; PG8_WAIT_L(0); PG8_MMA(0, 0, At, B0); PG8_BAR; PG8_SCHED;
            PG8_LDB(B1, 0, 1); PG8_STAGE(PG8_SB(0, 0), b2, voffB);
            PG8_BAR; PG8_WAIT_L(0); PG8_MMA(0, 1, At, B1); PG8_BAR;
            PG8_LDA(At, 0, 1); PG8_STAGE(PG8_SA(0, 0), a2, voffA);
            PG8_BAR; PG8_WAIT_L(0); PG8_MMA(1, 0, At, B0); PG8_BAR; PG8_SCHED;
            PG8_STAGE(PG8_SB(0, 1), b2 + hstep, voffB);
            PG8_WAIT_V(6); PG8_BAR; PG8_MMA(1, 1, At, B1); PG8_BAR;
            PG8_LDB(B0, 1, 0); PG8_SCHED; PG8_LDA(At, 1, 0); PG8_STAGE(PG8_SA(0, 1), a2 + hstep, voffA);
            PG8_WAIT_L(8); PG8_BAR; PG8_WAIT_L(0); PG8_MMA(0, 0, At, B0); PG8_BAR; PG8_SCHED;
            PG8_LDB(B1, 1, 1); PG8_STAGE(PG8_SB(1, 0), b3, voffB);
            PG8_BAR; PG8_WAIT_L(0); PG8_MMA(0, 1, At, B1); PG8_BAR;
            PG8_LDA(At, 1, 1); PG8_STAGE(PG8_SA(1, 0), a3, voffA);
            PG8_BAR; PG8_WAIT_L(0); PG8_MMA(1, 0, At, B0); PG8_BAR; PG8_SCHED;
            PG8_STAGE(PG8_SB(1, 1), b3 + hstep, voffB);
            PG8_WAIT_V(6); PG8_BAR; PG8_MMA(1, 1, At, B1); PG8_BAR;
            }
        }
        if constexpr (ALIGN_EPI) { if (wr == 0) PG8_BAR; }
        if constexpr (!Epi::AFTER_DRAIN) { E(acc, cur, wr, wc, fr, fq); S.done(cur); }
        if (!has_next) break;
#pragma unroll
        for (int a = 0; a < 2; ++a)
#pragma unroll
            for (int b = 0; b < 2; ++b)
#pragma unroll
                for (int m = 0; m < 4; ++m)
#pragma unroll
                    for (int n = 0; n < 2; ++n) acc[a][b][m][n] = (f32x4){0.f, 0.f, 0.f, 0.f};
        cur = nxt; cA = nA; cB = nB; ++ui;
        if constexpr (ALIGN_EPI) { if (wr == 1) PG8_BAR; }
    }
    PG8_WAIT_V(0);
    if constexpr (!ALIGN_EPI) { if (wr == 0) PG8_BAR; }
    PG8_BAR;
    if constexpr (Epi::AFTER_DRAIN) { E.fused(acc, cur, wr, wc, fr, fq, lds, wid, lane); S.done(cur); }
#undef PG8_SA
#undef PG8_SB
#undef PG8_STAGE
#undef PG8_LDA
#undef PG8_LDB
#undef PG8_MMA
#undef PG8_WAIT_V
#undef PG8_WAIT_L
#undef PG8_BAR
#undef PG8_SCHED
}
}


#define GAS __attribute__((address_space(1)))
#define LAS __attribute__((address_space(3)))
#define DEV __device__ __forceinline__
typedef unsigned short bf16;
typedef unsigned v4u __attribute__((ext_vector_type(4)));
typedef unsigned v2u __attribute__((ext_vector_type(2)));
typedef float f32x4 __attribute__((ext_vector_type(4)));
typedef float f32x2 __attribute__((ext_vector_type(2)));
typedef GAS unsigned gu32;
#define RLX_AGENT __ATOMIC_RELAXED, __HIP_MEMORY_SCOPE_AGENT
#define LDS_WAIT() asm volatile("s_waitcnt lgkmcnt(0)" ::: "memory")
#define VM_WAIT() asm volatile("s_waitcnt vmcnt(0)" ::: "memory")

constexpr int T = 16384, NSMP = 128, MR = T + NSMP, MP = 16640, DM = 1024;
constexpr int NIN = 5632, DFF = 2816, NGU = 5632;
constexpr int DEC_B = 32, DEC_T = 4;
constexpr int NCB = 1023;
constexpr float EPS = 1e-6f;
constexpr float LOG2E = 1.4426950408889634f;
#ifndef PROBE_REP
#define PROBE_REP 0
#endif

constexpr size_t O_YP = 0, O_YS = O_YP + (size_t)T * DM, O_PKC = O_YS + (size_t)NSMP * DM, O_PVC = O_PKC + (size_t)T * 128, O_PKS = O_PVC + (size_t)T * 128,
                 O_PVS = O_PKS + (size_t)T * 128, O_PKW = O_PVS + (size_t)T * 128, O_PVW = O_PKW + 512 * 128, O_PH = O_PVW + 512 * 128, O_SKC = O_PH + 4 * 128 * 128,
                 O_SVC = O_SKC + 128 * 128, O_SKS = O_SVC + 128 * 128, O_SVS = O_SKS + 128 * 128, O_SKW = O_SVS + 128 * 128, O_SVW = O_SKW + (size_t)32 * 512 * 128,
                 O_SH = O_SVW + (size_t)32 * 512 * 128, O_END = O_SH + (size_t)32 * 4 * 128 * 128;
static_assert(O_END == 31850496, "d_out size");

constexpr size_t MiB = 1u << 20;
constexpr size_t al(size_t x) { return (x + MiB - 1) / MiB * MiB; }
constexpr size_t WS_CTL = 0, CTL_ZERO_BYTES = MiB;
constexpr size_t WS_TBL = WS_CTL + MiB;
constexpr size_t WS_WIN = WS_TBL + MiB;
constexpr size_t WS_WGU = WS_WIN + al((size_t)NIN * DM * 2);
constexpr size_t WS_WD = WS_WGU + al((size_t)NGU * DM * 2);
constexpr size_t WS_WPA = WS_WD + al((size_t)DM * DFF * 2);
constexpr size_t WS_WPB = WS_WPA + MiB;
constexpr size_t WS_WO = WS_WPB + MiB;
constexpr size_t WS_W1K = WS_WO + 2 * MiB;
constexpr size_t WS_W1V = WS_W1K + MiB;
constexpr size_t WS_W2K = WS_W1V + MiB / 2, WS_W2V = WS_W2K + 65536;
constexpr size_t WS_W1PK = WS_W1K + MiB / 2, WS_W1PV = WS_TBL + MiB / 2;
constexpr size_t WS_XN = WS_W1V + MiB;
constexpr size_t WS_QA = WS_XN + al((size_t)MP * DM * 2);
constexpr size_t WS_KS = WS_QA + al((size_t)MP * 512 * 2);
constexpr size_t WS_VS = WS_KS + 4 * MiB, WS_KW = WS_VS + 4 * MiB, WS_VW = WS_KW + 4 * MiB;
constexpr size_t WS_CKP = WS_VW + 4 * MiB;
constexpr size_t WS_CVP = WS_CKP + 5 * MiB;
constexpr size_t WS_GA = WS_CVP + 5 * MiB;
constexpr size_t WS_HQ = WS_GA + 2 * MiB;
constexpr size_t WS_HF = WS_HQ + al((size_t)MP * 512 * 2);
constexpr size_t WS_HI = WS_HF + al((size_t)MP * 512 * 4);
constexpr size_t WS_HG = WS_HI + al((size_t)MP * 512 * 2);
constexpr size_t WS_SGA = WS_HG + al((size_t)MP * 512 * 2);
constexpr size_t WS_SGB = WS_SGA + al((size_t)MP * DM * 2);
constexpr size_t WS_ACK = WS_SGB + al((size_t)MP * DM * 2);
constexpr size_t WS_ACV = WS_ACK + 128 * MiB;
constexpr size_t WS_TK = WS_ACV + 128 * MiB;
constexpr size_t WS_TV = WS_TK + 33 * MiB;
constexpr size_t WS_KCS = WS_TV + 33 * MiB;
constexpr size_t WS_VCS = WS_KCS + 8 * MiB;
constexpr size_t WS_KCP = WS_VCS + 8 * MiB;
constexpr size_t WS_VCP = WS_KCP + MiB;
constexpr size_t WS_HL = WS_VCP + MiB;
constexpr size_t WS_HD = WS_HL + 64 * MiB;
constexpr size_t WS_HIN = WS_HD + MiB;
constexpr size_t WS_HQT = WS_HIN + 32 * MiB;
constexpr size_t WS_HO = WS_HQT + 32 * MiB;
constexpr size_t WS_OA = WS_HO + MiB;
constexpr size_t WS_OB = WS_OA + al((size_t)MP * 512 * 2);
constexpr size_t WS_PT = WS_OB + al((size_t)MP * 512 * 2);
constexpr size_t WS_MG = WS_PT + al((size_t)MP * DM * 4);
constexpr size_t WS_X1 = WS_MG + al((size_t)MP * DM * 2);
constexpr size_t WS_FF = WS_X1 + al((size_t)MP * DM * 4);
constexpr size_t WS_END = WS_FF + al((size_t)MP * DFF * 2);
constexpr int CTL_Q = 16384 + 512;
constexpr int CTL_PC = 98304;
constexpr size_t WS_XS = WS_TBL + 128 * 1024;
constexpr int CTL_HB = 16384;
constexpr int TB_LB = 0, TB_HBK = 512, TB_HBV = 640, TB_BIAS = 768  , TB_END = 768 + 8 * 129;

constexpr int RING_BYTES = 139264;
constexpr int LDSCTL_OFF = RING_BYTES;
constexpr int LDSBIAS_OFF = RING_BYTES + 64;
constexpr int LDS_BYTES = 147456;
static_assert(LDSBIAS_OFF + 8 * 129 * 4 <= LDS_BYTES, "LDS map");

__device__ __constant__ unsigned char T5_BUCKET[129] = {0, 1, 2, 3, 4, 5, 6, 7, 8, 9, 10, 11, 12, 13, 14, 15, 16, 16, 16, 17, 17, 18, 18, 18, 19, 19, 19, 20, 20, 20, 20, 21, 21, 21, 21, 22, 22, 22, 22, 22, 23, 23, 23, 23, 23, 23, 24, 24, 24, 24, 24, 24, 25, 25, 25, 25, 25, 25, 25, 26, 26, 26, 26, 26, 26, 26, 26, 27, 27, 27, 27, 27, 27, 27, 27, 27, 27, 28, 28, 28, 28, 28, 28, 28, 28, 28, 28, 29, 29, 29, 29, 29, 29, 29, 29, 29, 29, 29, 29, 30, 30, 30, 30, 30, 30, 30, 30, 30, 30, 30, 30, 30, 30, 31, 31, 31, 31, 31, 31, 31, 31, 31, 31, 31, 31, 31, 31, 31, 31};

DEV unsigned f2bf(float f) { unsigned u = __builtin_bit_cast(unsigned, f); return (u + 0x7fffu + ((u >> 16) & 1u)) >> 16; }
DEV unsigned pk2(float lo, float hi) { return f2bf(lo) | (f2bf(hi) << 16); }
DEV float bf2f(unsigned h) { return __builtin_bit_cast(float, h << 16); }
DEV float bflo(unsigned w) { return __builtin_bit_cast(float, w << 16); }
DEV float bfhi(unsigned w) { return __builtin_bit_cast(float, w & 0xffff0000u); }
DEV float wave_sum(float v) {
#pragma unroll
    for (int o = 1; o < 64; o <<= 1) v += __shfl_xor(v, o);
    return v;
}
DEV float wave_max(float v) {
#pragma unroll
    for (int o = 1; o < 64; o <<= 1) v = fmaxf(v, __shfl_xor(v, o));
    return v;
}
DEV float sigmoidf(float x) { return __builtin_amdgcn_rcpf(1.0f + __expf(-x)); }
DEV float siluf(float x) { return x * __builtin_amdgcn_rcpf(1.0f + __expf(-x)); }
DEV float gelu_tanh(float x) { const float u = 0.7978845608028654f * (x + 0.044715f * x * x * x); const float e = __expf(2.0f * u); const float th = 1.0f - 2.0f * __builtin_amdgcn_rcpf(e + 1.0f); return 0.5f * x * (1.0f + th); }

typedef short ab8 __attribute__((ext_vector_type(8)));
typedef short s16x4 __attribute__((ext_vector_type(4)));
#define NEG_INF (-__builtin_inff())
DEV float dpp_xor1(float v) { return __builtin_bit_cast(float, __builtin_amdgcn_update_dpp(0, __builtin_bit_cast(int, v), 0xB1, 0xF, 0xF, true)); }
DEV float dpp_xor2(float v) { return __builtin_bit_cast(float, __builtin_amdgcn_update_dpp(0, __builtin_bit_cast(int, v), 0x4E, 0xF, 0xF, true)); }
DEV s16x4 vtr(const LAS unsigned char* p) { typedef short v4i16_t __attribute__((ext_vector_type(4))); return __builtin_bit_cast(s16x4, __builtin_amdgcn_ds_read_tr16_b64_v4i16((LAS v4i16_t*)p)); }
DEV unsigned cvtpk(float lo, float hi) { typedef float f2 __attribute__((ext_vector_type(2))); typedef __bf16 b2 __attribute__((ext_vector_type(2))); f2 v = {lo, hi}; b2 b = __builtin_convertvector(v, b2); return __builtin_bit_cast(unsigned, b); }
#define XB_TMO      128
#define XB_XCNT(j)  (256  + 64 * (j))
#define XB_XSUB(j)  (1280 + 64 * (j))
#define XB_XGEN(j)  (2304 + 64 * (j))
#define XB_TOP      3328
#define XB_TOPGEN   3392
#define XCD_BAR_WORDS 3456
#define XB_SPIN_CAP (1u << 18)
DEV unsigned xb_ld(unsigned* p)              { return __hip_atomic_load(p, __ATOMIC_RELAXED, __HIP_MEMORY_SCOPE_AGENT); }
DEV unsigned xb_add(unsigned* p, unsigned v) { return __hip_atomic_fetch_add(p, v, __ATOMIC_RELAXED, __HIP_MEMORY_SCOPE_AGENT); }
DEV unsigned xb_xcc_id() { return (unsigned)__builtin_amdgcn_s_getreg((3 << 11) | 20) & 0xFu; }
#define XB_SPIN(cond, bar) do { unsigned _sp = 0; while (cond) { __builtin_amdgcn_s_sleep(1); \
    if ((++_sp & 255u) == 0u) { if (xb_ld(&(bar)[XB_TMO])) break; if (_sp > XB_SPIN_CAP) { atomicAdd(&(bar)[XB_TMO], 1u); break; } } } } while (0)
struct XcdBarrier { unsigned* bar; unsigned x; volatile LAS unsigned* st; };
DEV XcdBarrier xcd_barrier_post(unsigned* bar, volatile LAS unsigned* st) {
    XcdBarrier b; b.bar = bar; b.x = xb_xcc_id(); b.st = st;
    if (threadIdx.x == 0) (void)xb_add(&bar[XB_XCNT(b.x)], 1u);
    return b;
}
DEV void xcd_barrier_complete(unsigned* bar, unsigned x, unsigned& nloc, unsigned& nx) {
    const unsigned G = gridDim.x * gridDim.y * gridDim.z;
    unsigned sum, cnt, mine, sp = 0u;
    for (;;) {
        sum = 0u; cnt = 0u; mine = 0u;
#pragma unroll
        for (unsigned j = 0; j < 16; ++j) { const unsigned c = xb_ld(&bar[XB_XCNT(j)]); sum += c; cnt += (c > 0u) ? 1u : 0u; mine = (j == x) ? c : mine; }
        if (sum == G) break;
        __builtin_amdgcn_s_sleep(1);
        if ((++sp & 255u) == 0u) { if (xb_ld(&bar[XB_TMO])) break; if (sp > XB_SPIN_CAP) { atomicAdd(&bar[XB_TMO], 1u); break; } }
    }
    nloc = mine > 0u ? mine : 1u; nx = cnt > 0u ? cnt : 1u;
}
DEV void xcd_barrier(const XcdBarrier& b) {
    asm volatile("s_waitcnt vmcnt(0)" ::: "memory");
    __syncthreads();
    if (threadIdx.x == 0) {
        unsigned* bar = b.bar;
        __builtin_amdgcn_s_waitcnt(0);
        unsigned nloc = b.st[0], nx = b.st[1];
        if (nloc == 0u) { xcd_barrier_complete(bar, b.x, nloc, nx); b.st[0] = nloc; b.st[1] = nx; }
        const unsigned old = xb_add(&bar[XB_XSUB(b.x)], 1u);
        const unsigned gen = old / nloc;
        if (old + 1u == (gen + 1u) * nloc) {
            __builtin_amdgcn_fence(__ATOMIC_RELEASE, "agent");
            asm volatile("s_waitcnt vmcnt(0)" ::: "memory");
            const unsigned og = xb_add(&bar[XB_TOP], 1u);
            const unsigned tg = og / nx;
            if (og + 1u == (tg + 1u) * nx) xb_add(&bar[XB_TOPGEN], 1u);
            else XB_SPIN(xb_ld(&bar[XB_TOPGEN]) == tg, bar);
            __builtin_amdgcn_fence(__ATOMIC_ACQUIRE, "agent");
            xb_add(&bar[XB_XGEN(b.x)], 1u);
            asm volatile("s_waitcnt vmcnt(0)" ::: "memory");
        } else {
            XB_SPIN(xb_ld(&bar[XB_XGEN(b.x)]) == gen, bar);
            __builtin_amdgcn_fence(__ATOMIC_ACQUIRE, "agent");
            asm volatile("s_waitcnt vmcnt(0)" ::: "memory");
        }
    }
    __syncthreads();
}

struct Args { const void* in[29]; float* out; unsigned char* ws; int ph_lo, ph_hi; };
struct Frame {
    const Args& A;
    LAS unsigned char* lds;
    int tid, lane, wave, vcu, G;
    float* out; unsigned char* ws;
};
template <class Tp> DEV Tp* wsp(const Frame& F, size_t off) { return (Tp*)(F.ws + off); }

DEV void tr_item(const float* src, int ldsrc, int sk0, int scol0, bf16* dst, int ldd, int drow0, int dk0, int nvalid, LAS float* scr, int lane) {
    { float t[32];
#pragma unroll
      for (int i = 0; i < 32; ++i) { const int kk = 2 * i + (lane >> 5), n = lane & 31; t[i] = (n < nvalid) ? src[(size_t)(sk0 + kk) * ldsrc + scol0 + n] : 0.f; }
#pragma unroll
      for (int i = 0; i < 32; ++i) { const int kk = 2 * i + (lane >> 5), n = lane & 31; scr[kk * 33 + n] = t[i]; } }
    LDS_WAIT(); asm volatile("" ::: "memory");
    const int c = lane & 7;
#pragma unroll
    for (int j = 0; j < 4; ++j) { const int n = (lane >> 3) + 8 * j; const LAS float* s = scr + (8 * c) * 33 + n;
        v4u o; o.x = pk2(s[0 * 33], s[1 * 33]); o.y = pk2(s[2 * 33], s[3 * 33]); o.z = pk2(s[4 * 33], s[5 * 33]); o.w = pk2(s[6 * 33], s[7 * 33]);
        *(v4u*)(dst + (size_t)(drow0 + n) * ldd + dk0 + 8 * c) = o; }
    LDS_WAIT(); asm volatile("" ::: "memory");
}
DEV void tr_item_frag(const float* src, int sk0, int scol0, bf16* dst, LAS float* scr, int lane) {
    { float t[32];
#pragma unroll
      for (int i = 0; i < 32; ++i) { const int kk = 2 * i + (lane >> 5), n = lane & 31; t[i] = src[(size_t)(sk0 + kk) * 128 + scol0 + n]; }
#pragma unroll
      for (int i = 0; i < 32; ++i) { const int kk = 2 * i + (lane >> 5), n = lane & 31; scr[kk * 33 + n] = t[i]; } }
    LDS_WAIT(); asm volatile("" ::: "memory");
    const int c = lane & 7, k0 = sk0 + 8 * c;
#pragma unroll
    for (int j = 0; j < 4; ++j) { const int n = (lane >> 3) + 8 * j, e = scol0 + n; const LAS float* s = scr + (8 * c) * 33 + n;
        v4u o; o.x = pk2(s[0 * 33], s[1 * 33]); o.y = pk2(s[2 * 33], s[3 * 33]); o.z = pk2(s[4 * 33], s[5 * 33]); o.w = pk2(s[6 * 33], s[7 * 33]);
        *(v4u*)(dst + (size_t)((e >> 4) * 64 + (k0 >> 5)) * 512 + ((k0 >> 3) & 3) * 128 + (e & 15) * 8) = o; }
    LDS_WAIT(); asm volatile("" ::: "memory");
}
DEV void rms_row_bf16(const float* xrow, const float* gain, bf16* orow, int lane) {
    const f32x4* xr = (const f32x4*)xrow + lane; const f32x4* gr = (const f32x4*)gain + lane;
    f32x4 v[4]; float s = 0.f;
#pragma unroll
    for (int j = 0; j < 4; ++j) { v[j] = xr[64 * j]; s += (v[j].x * v[j].x + v[j].y * v[j].y) + (v[j].z * v[j].z + v[j].w * v[j].w); }
    const float r = 1.0f / sqrtf(wave_sum(s) * (1.f / DM) + EPS);
    v2u* o8 = (v2u*)orow + lane;
#pragma unroll
    for (int j = 0; j < 4; ++j) { const f32x4 g = gr[64 * j]; v2u w; w.x = pk2(v[j].x * r * g.x, v[j].y * r * g.y); w.y = pk2(v[j].z * r * g.z, v[j].w * r * g.w); o8[64 * j] = w; }
}
DEV void rms_row_f32(const float* xrow, const float* gain, float* orow, int lane) {
    const f32x4* xr = (const f32x4*)xrow + lane; const f32x4* gr = (const f32x4*)gain + lane;
    f32x4 v[4]; float s = 0.f;
#pragma unroll
    for (int j = 0; j < 4; ++j) { v[j] = xr[64 * j]; s += (v[j].x * v[j].x + v[j].y * v[j].y) + (v[j].z * v[j].z + v[j].w * v[j].w); }
    const float r = 1.0f / sqrtf(wave_sum(s) * (1.f / DM) + EPS);
    f32x4* o = (f32x4*)orow + lane;
#pragma unroll
    for (int j = 0; j < 4; ++j) { const f32x4 g = gr[64 * j]; o[64 * j] = v[j] * r * g; }
}

template <bool OUTF32, class SrcFn, class DstFn>
DEV void rms_rows(int m0, int mstep, int mend, SrcFn src, DstFn dst, const float* gain, int lane) {
    f32x4 g[4];
#pragma unroll
    for (int j = 0; j < 4; ++j) g[j] = ((const f32x4*)gain)[lane + 64 * j];
    for (int mb = m0; mb < mend; mb += 4 * mstep) {
        f32x4 v[4][4];
#pragma unroll
        for (int i = 0; i < 4; ++i) { const int m = mb + i * mstep; if (m < mend) { const f32x4* xr = (const f32x4*)src(m) + lane;
#pragma unroll
            for (int j = 0; j < 4; ++j) v[i][j] = xr[64 * j]; } }
#pragma unroll
        for (int i = 0; i < 4; ++i) { const int m = mb + i * mstep; if (m < mend) {
            float s = 0.f;
#pragma unroll
            for (int j = 0; j < 4; ++j) s += (v[i][j].x * v[i][j].x + v[i][j].y * v[i][j].y) + (v[i][j].z * v[i][j].z + v[i][j].w * v[i][j].w);
            const float r = 1.0f / sqrtf(wave_sum(s) * (1.f / DM) + EPS);
            if (OUTF32) { f32x4* o = (f32x4*)dst(m) + lane;
#pragma unroll
                for (int j = 0; j < 4; ++j) o[64 * j] = v[i][j] * r * g[j]; }
            else { v2u* o8 = (v2u*)dst(m) + lane;
#pragma unroll
                for (int j = 0; j < 4; ++j) { v2u w; w.x = pk2(v[i][j].x * r * g[j].x, v[i][j].y * r * g[j].y); w.y = pk2(v[i][j].z * r * g[j].z, v[i][j].w * r * g[j].w); o8[64 * j] = w; } } } }
    }
}
constexpr int I_IN = 16 * 176, I_GU = 16 * 176, I_D = 44 * 32, I_PA = 8 * 32, I_O = 16 * 32, I_W1 = 2 * 16 * 4;
constexpr int I_W1P = 32 * 4, NITEMS = I_IN + I_GU + I_D + 2 * I_PA + I_O + 2 * I_W1 + 8 + 2 * I_W1P;
constexpr int DEF_I0 = 2 * I_W1P + I_IN, DEF_I1 = DEF_I0 + I_GU + I_D + 2 * I_PA + I_O;
constexpr int DEF_NTR = DEF_I1 - DEF_I0, DEF_NWIN = 2 * 32 * 64, DEF_N = DEF_NTR + DEF_NWIN;
DEV void tr_dispatch(Frame& F, int it, LAS float* scr, int lane) {
    bf16* WIN = wsp<bf16>(F, WS_WIN); bf16* WGU = wsp<bf16>(F, WS_WGU); bf16* WD = wsp<bf16>(F, WS_WD);
    bf16* WPA = wsp<bf16>(F, WS_WPA); bf16* WPB = wsp<bf16>(F, WS_WPB); bf16* WO = wsp<bf16>(F, WS_WO);
    bf16* W1K = wsp<bf16>(F, WS_W1K); bf16* W1V = wsp<bf16>(F, WS_W1V);
        int r = it;
        if (r < 2 * I_W1P) { const int ty = r / I_W1P, rr = r % I_W1P; tr_item_frag(ty ? ((const float*)F.A.in[16]) : ((const float*)F.A.in[13]), 64 * (rr >> 2), 32 * (rr & 3), wsp<bf16>(F, ty ? WS_W1PV : WS_W1PK), scr, lane); return; }
        r -= 2 * I_W1P;
        if (r < I_IN) { const int kb = r / 176, nb = r % 176, n0 = 32 * nb;
            int sc, nv = 32;
            if (n0 < 1280) sc = n0; else if (n0 < 5376) sc = n0 + 24; else if (n0 < 5400) { sc = n0 - 5376 + 1280; nv = 5400 - n0 < 32 ? 5400 - n0 : 32; } else { sc = 0; nv = 0; }
            tr_item(((const float*)F.A.in[11]), 5400, 64 * kb, sc, WIN, DM, n0, 64 * kb, nv, scr, lane); return; }
        r -= I_IN;
        if (r < I_GU) { const int kb = r / 176, nb = r % 176, n0 = 32 * nb, p = n0 >> 8, j = n0 & 255;
            const float* src = (j < 128) ? ((const float*)F.A.in[25]) : ((const float*)F.A.in[26]); const int sc = 128 * p + (j & 127);
            tr_item(src, DFF, 64 * kb, sc, WGU, DM, n0, 64 * kb, 32, scr, lane); return; }
        r -= I_GU;
        if (r < I_D) { const int kb = r / 32, nb = r % 32; tr_item(((const float*)F.A.in[27]), DM, 64 * kb, 32 * nb, WD, DFF, 32 * nb, 64 * kb, 32, scr, lane); return; }
        r -= I_D;
        if (r < I_PA) { const int kb = r / 32, nb = r % 32; tr_item(((const float*)F.A.in[21]), DM, 64 * kb, 32 * nb, WPA, 512, 32 * nb, 64 * kb, 32, scr, lane); return; }
        r -= I_PA;
        if (r < I_PA) { const int kb = r / 32, nb = r % 32; tr_item(((const float*)F.A.in[22]), DM, 64 * kb, 32 * nb, WPB, 512, 32 * nb, 64 * kb, 32, scr, lane); return; }
        r -= I_PA;
        if (r < I_O) { const int kb = r / 32, nb = r % 32; tr_item(((const float*)F.A.in[23]), DM, 64 * kb, 32 * nb, WO, DM, 32 * nb, 64 * kb, 32, scr, lane); return; }
        r -= I_O;
        if (r >= 2 * I_W1) { r -= 2 * I_W1; const int ty = r >> 2, kb = (r >> 1) & 1, nb = r & 1;
            tr_item(ty ? ((const float*)F.A.in[17]) : ((const float*)F.A.in[14]), 64, 64 * kb, 32 * nb, wsp<bf16>(F, ty ? WS_W2V : WS_W2K), 128, 32 * nb, 64 * kb, 32, scr, lane); return; }
        { const int ty = r / I_W1; r -= ty * I_W1;
          const int half = r / 64, rr = r % 64, kb = rr / 4, nb = rr % 4;
          tr_item(ty ? ((const float*)F.A.in[16]) : ((const float*)F.A.in[13]), 128, half * 1024 + 64 * kb, 32 * nb, ty ? W1V : W1K, DM, half * 128 + 32 * nb, 64 * kb, 32, scr, lane); }
}
DEV void win_copy_item(Frame& F, int it, int lane) {
    const int ty = it >> 11, b = (it >> 6) & 31, pc = it & 63;
    const f32x4* src = (const f32x4*)((ty ? ((const float*)F.A.in[7]) : ((const float*)F.A.in[6])) + (size_t)(b * 512 + 4) * 128) + pc * 256 + lane;
    f32x4* dst = (f32x4*)(F.out + (ty ? O_SVW : O_SKW) + (size_t)(b * 512) * 128) + pc * 256 + lane;
    f32x4 t[4];
#pragma unroll
    for (int j = 0; j < 4; ++j) if (pc * 256 + lane + 64 * j < 16256) t[j] = src[64 * j];
#pragma unroll
    for (int j = 0; j < 4; ++j) if (pc * 256 + lane + 64 * j < 16256) dst[64 * j] = t[j];
}
DEV void p0_prologue(Frame& F, bool first) {
    LAS float* scr = (LAS float*)(F.lds + F.wave * 16384);
    const int gw = F.vcu * 8 + F.wave, NGW = F.G * 8, lane = F.lane;
    bf16* WIN = wsp<bf16>(F, WS_WIN); bf16* WGU = wsp<bf16>(F, WS_WGU); bf16* WD = wsp<bf16>(F, WS_WD);
    bf16* WPA = wsp<bf16>(F, WS_WPA); bf16* WPB = wsp<bf16>(F, WS_WPB); bf16* WO = wsp<bf16>(F, WS_WO);
    bf16* W1K = wsp<bf16>(F, WS_W1K); bf16* W1V = wsp<bf16>(F, WS_W1V);
    for (int it = gw; it < NITEMS; it += NGW) { if (it >= DEF_I0 && it < DEF_I1) continue; tr_dispatch(F, it, scr, lane); }
    bf16* XN = wsp<bf16>(F, WS_XN);
    { const float* xp = (const float*)F.A.in[0]; const float* xs = (const float*)F.A.in[1];
      rms_rows<false>(gw, NGW, MR, [&](int m) { return m < T ? xp + (size_t)m * DM : xs + (size_t)(m - T) * DM; }, [&](int m) { return XN + (size_t)m * DM; }, ((const float*)F.A.in[10]), lane);
      for (int m = MR + gw; m < MP; m += NGW) { v4u z = {0u, 0u, 0u, 0u}; v4u* o = (v4u*)(XN + (size_t)m * DM); o[lane] = z; o[lane + 64] = z; } }
    if (first && F.vcu >= F.G - 17 && F.vcu < F.G - 1) {
        const int jb = F.vcu - (F.G - 17), tid = F.tid, e = tid & 127, ty = (tid >> 7) & 1, half = tid >> 8;
        const float* pe = ty ? ((const float*)F.A.in[15]) : ((const float*)F.A.in[12]); const float* w1 = ty ? ((const float*)F.A.in[16]) : ((const float*)F.A.in[13]);
        float s0 = 0.f, s1 = 0.f;
#pragma unroll 8
        for (int k = jb * 128 + half * 64; k < jb * 128 + half * 64 + 64; k += 2) { s0 += pe[k] * w1[(size_t)k * 128 + e]; s1 += pe[k + 1] * w1[(size_t)(k + 1) * 128 + e]; }
        atomicAdd(wsp<float>(F, WS_CTL) + CTL_HB + ty * 128 + e, s0 + s1);
    }
    if (F.vcu == F.G - 1) {
        float* TB = wsp<float>(F, WS_TBL); const int tid = F.tid;
        { const float l0 = ((const float*)F.A.in[19])[tid], l1 = ((const float*)F.A.in[19])[512 + tid]; TB[TB_LB + tid] = 1.0f / (1.0f + __expf(l1 - l0)); }
        for (int i = tid; i < 8 * 129; i += 512) { const int h = i / 129, n = i % 129; TB[TB_BIAS + i] = ((const float*)F.A.in[18])[(int)T5_BUCKET[n] * 8 + h]; }
    }
}

DEV void static_unit(int wgid0, int nM, int nN, int& pm, int& pn) {
    const int nwg = nM * nN; int wgid = wgid0;
    { const int q = nwg / pg8::NXCD, r = nwg % pg8::NXCD, xcd = wgid % pg8::NXCD, off = wgid / pg8::NXCD; wgid = (xcd < r ? xcd * (q + 1) : r * (q + 1) + (xcd - r) * q) + off; }
    const int nig = pg8::WGM * nN, gid = wgid / nig, fm = gid * pg8::WGM, gsz = (nM - fm) < pg8::WGM ? (nM - fm) : pg8::WGM;
    pm = fm + ((wgid % nig) % gsz); pn = (wgid % nig) / gsz;
}
struct SchedOne {
    const char* A; const char* B; int nM, nN, K, G, c;
    DEV bool next(int i, pg8::Unit& u) const { const long L = (long)i * G + c; if (L >= (long)nM * nN) return false; int pm = 0, pn = 0; static_unit((int)L, nM, nN, pm, pn); u.pm = pm; u.pn = pn; u.gi = 0; return true; }
    DEV void ptrs(const pg8::Unit& u, const char*& a, const char*& b) const { a = A + (size_t)u.pm * 512 * K; b = B + (size_t)u.pn * 512 * K; }
    DEV void a_ready(const pg8::Unit&) const {}
    DEV void done(const pg8::Unit&) const {}
};
constexpr int P1_NM = MP / 256, P1_NN = NIN / 256, P1_U0 = P1_NM * P1_NN;
struct SchedP1 {
    const char *A0, *B0, *A1, *B1, *A2, *B2; int G, c;
    DEV bool next(int i, pg8::Unit& u) const { const long L = (long)i * G + c; if (L >= P1_U0 + 512) return false;
        int pm = 0, pn = 0; static_unit(L < P1_U0 ? (int)L : 0, P1_NM, P1_NN, pm, pn);
        const int l = (int)L - P1_U0; const bool cmp = L >= P1_U0;
        u.pm = cmp ? (l & 255) : pm; u.pn = cmp ? 0 : pn; u.gi = cmp ? 1 + (l >> 8) : 0; return true; }
    DEV void ptrs(const pg8::Unit& u, const char*& a, const char*& b) const {
        if (u.gi == 0) { a = A0 + (size_t)u.pm * 524288; b = B0 + (size_t)u.pn * 524288; } else if (u.gi == 1) { a = A1 + (size_t)u.pm * 524288; b = B1; } else { a = A2 + (size_t)u.pm * 524288; b = B2; } }
    DEV void a_ready(const pg8::Unit&) const {}
    DEV void done(const pg8::Unit&) const {}
};

DEV void st_bf16x8(bf16* p, const f32x4 a, const f32x4 b) { v4u w; w.x = pg8::cvt_pk_bf16(a[0], a[1]); w.y = pg8::cvt_pk_bf16(a[2], a[3]); w.z = pg8::cvt_pk_bf16(b[0], b[1]); w.w = pg8::cvt_pk_bf16(b[2], b[3]); *(v4u*)p = w; }
DEV f32x4 map_silu(f32x4 v) { return (f32x4){siluf(v[0]), siluf(v[1]), siluf(v[2]), siluf(v[3])}; }
DEV f32x4 map_sigm(f32x4 v) { return (f32x4){sigmoidf(v[0]), sigmoidf(v[1]), sigmoidf(v[2]), sigmoidf(v[3])}; }

#define EPI_ROWS(...) _Pragma("unroll") for (int ai = 0; ai < 2; ++ai) _Pragma("unroll") for (int m = 0; m < 4; ++m) { const int r = u.pm * 256 + ai * 128 + wr * 64 + m * 16 + fr; __VA_ARGS__ }
constexpr float QSCALE_ = 0.125f * 1.4426950408889634f;
struct EpiP1 {
    static constexpr bool PERM = true, AFTER_DRAIN = false;
    float* out; bf16 *QA, *KS, *VS, *KW, *VW, *CKP, *CVP, *HQ, *HI, *HG, *SGA, *SGB, *TK, *TV; float *HF, *GA;
    DEV void operator()(const f32x4 (&acc)[2][2][4][2], const pg8::Unit& u, int wr, int wc, int fr_, int fq_) const { int fr = fr_, fq = fq_; asm volatile("" : "+v"(fr), "+v"(fq));
        const int cw = wc * 32 + 8 * fq;
        if (u.gi != 0) { bf16* Tb = (u.gi == 1) ? TK : TV;
            EPI_ROWS({ _Pragma("unroll") for (int bj = 0; bj < 2; ++bj) st_bf16x8(Tb + (size_t)r * 256 + bj * 128 + cw, acc[ai][bj][m][0], acc[ai][bj][m][1]); })
            return; }
        const int pn = u.pn;
        if (pn < 2) { EPI_ROWS({ if (r < MR) { _Pragma("unroll") for (int bj = 0; bj < 2; ++bj) st_bf16x8(QA + (size_t)r * 512 + pn * 256 + bj * 128 + cw, acc[ai][bj][m][0] * QSCALE_, acc[ai][bj][m][1] * QSCALE_); } }) }
        else if (pn == 2) {
            EPI_ROWS({ if (r < MR) { _Pragma("unroll") for (int bj = 0; bj < 2; ++bj) { const f32x4 a = acc[ai][bj][m][0], b = acc[ai][bj][m][1];
                float* o = (r < T) ? out + (bj ? O_PVC : O_PKC) + (size_t)r * 128 + cw : out + (bj ? O_SVC : O_SKC) + (size_t)(r - T) * 128 + cw;
                *(f32x4*)o = a; *(f32x4*)(o + 4) = b;
                if (r < T) { const int kv = cw >> 6, d = cw & 63; st_bf16x8((bj ? CVP : CKP) + ((size_t)(kv * 1024 + (r >> 4)) * 1024 + (r & 15) * 64 + d), a, b); } } } }) }
        else if (pn == 3) {
            EPI_ROWS({ if (r < MR) { _Pragma("unroll") for (int bj = 0; bj < 2; ++bj) { const f32x4 a = acc[ai][bj][m][0], b = acc[ai][bj][m][1];
                float* o = (r < T) ? out + (bj ? O_PVS : O_PKS) + (size_t)r * 128 + cw : out + (bj ? O_SVS : O_SKS) + (size_t)(r - T) * 128 + cw;
                *(f32x4*)o = a; *(f32x4*)(o + 4) = b;
                if (r < T) st_bf16x8((bj ? VS : KS) + (size_t)r * 128 + cw, a, b); } } }) }
        else if (pn == 4) {
            EPI_ROWS({ if (r < MR) { _Pragma("unroll") for (int bj = 0; bj < 2; ++bj) { const f32x4 a = acc[ai][bj][m][0], b = acc[ai][bj][m][1];
                if (r < T) { st_bf16x8((bj ? VW : KW) + (size_t)r * 128 + cw, a, b);
                    if (r >= T - 512) { float* o = out + (bj ? O_PVW : O_PKW) + (size_t)(r - (T - 512)) * 128 + cw; *(f32x4*)o = a; *(f32x4*)(o + 4) = b; } }
                else { const int rs = r - T; float* o = out + (bj ? O_SVW : O_SKW) + (size_t)((rs >> 2) * 512 + 508 + (rs & 3)) * 128 + cw; *(f32x4*)o = a; *(f32x4*)(o + 4) = b; } } } }) }
        else if (pn < 7) { EPI_ROWS({ if (r < MR) { _Pragma("unroll") for (int bj = 0; bj < 2; ++bj) st_bf16x8(HQ + (size_t)r * 512 + (pn - 5) * 256 + bj * 128 + cw, map_silu(acc[ai][bj][m][0]), map_silu(acc[ai][bj][m][1])); } }) }
        else if (pn < 9) { EPI_ROWS({ if (r < MR) { _Pragma("unroll") for (int bj = 0; bj < 2; ++bj) { float* o = HF + (size_t)r * 512 + (pn - 7) * 256 + bj * 128 + cw; *(f32x4*)o = acc[ai][bj][m][0]; *(f32x4*)(o + 4) = acc[ai][bj][m][1]; } } }) }
        else if (pn < 11) { EPI_ROWS({ if (r < MR) { _Pragma("unroll") for (int bj = 0; bj < 2; ++bj) st_bf16x8(HI + (size_t)r * 512 + (pn - 9) * 256 + bj * 128 + cw, acc[ai][bj][m][0], acc[ai][bj][m][1]); } }) }
        else if (pn < 13) { EPI_ROWS({ if (r < MR) { _Pragma("unroll") for (int bj = 0; bj < 2; ++bj) st_bf16x8(HG + (size_t)r * 512 + (pn - 11) * 256 + bj * 128 + cw, map_silu(acc[ai][bj][m][0]), map_silu(acc[ai][bj][m][1])); } }) }
        else if (pn < 17) { EPI_ROWS({ if (r < MR) { _Pragma("unroll") for (int bj = 0; bj < 2; ++bj) st_bf16x8(SGA + (size_t)r * 1024 + (pn - 13) * 256 + bj * 128 + cw, map_sigm(acc[ai][bj][m][0]), map_sigm(acc[ai][bj][m][1])); } }) }
        else if (pn < 21) { EPI_ROWS({ if (r < MR) { _Pragma("unroll") for (int bj = 0; bj < 2; ++bj) st_bf16x8(SGB + (size_t)r * 1024 + (pn - 17) * 256 + bj * 128 + cw, map_sigm(acc[ai][bj][m][0]), map_sigm(acc[ai][bj][m][1])); } }) }
        else { if (cw < 24) { EPI_ROWS({ if (r < MR) { float* o = GA + (size_t)r * 24 + cw; *(f32x4*)o = map_sigm(acc[ai][0][m][0]); *(f32x4*)(o + 4) = map_sigm(acc[ai][0][m][1]); } }) } }
    }
};
#define EPI_ALL(...) _Pragma("unroll") for (int ai = 0; ai < 2; ++ai) _Pragma("unroll") for (int m = 0; m < 4; ++m) { const int r = u.pm * 256 + ai * 128 + wr * 64 + m * 16 + fr; if (r < MR) { \
    _Pragma("unroll") for (int bj = 0; bj < 2; ++bj) _Pragma("unroll") for (int n = 0; n < 2; ++n) { const int c = u.pn * 256 + bj * 128 + wc * 32 + 16 * n + 4 * fq; const f32x4 v = acc[ai][bj][m][n]; __VA_ARGS__ } } }
DEV f32x4 ld_bf16x4(const bf16* p) { const v2u w = *(const v2u*)p; return (f32x4){bflo(w.x), bfhi(w.x), bflo(w.y), bfhi(w.y)}; }
DEV void st_bf16x4(bf16* p, const f32x4 v) { v2u w; w.x = pg8::cvt_pk_bf16(v[0], v[1]); w.y = pg8::cvt_pk_bf16(v[2], v[3]); *(v2u*)p = w; }
struct EpiProjA {
    static constexpr bool PERM = false, AFTER_DRAIN = false; const bf16* SG; float* PT;
    DEV void apply(int r, int c, const f32x4 v) const { *(f32x4*)(PT + (size_t)r * DM + c) = v * ld_bf16x4(SG + (size_t)r * DM + c); }
    DEV void operator()(const f32x4 (&acc)[2][2][4][2], const pg8::Unit& u, int wr, int wc, int fr_, int fq_) const { int fr = fr_, fq = fq_; asm volatile("" : "+v"(fr), "+v"(fq));
        EPI_ALL({ apply(r, c, v); }) }
};
struct EpiProjB {
    static constexpr bool PERM = false, AFTER_DRAIN = false; const bf16* SG; const float* PT; bf16* MG;
    DEV void apply(int r, int c, const f32x4 v) const { st_bf16x4(MG + (size_t)r * DM + c, *(const f32x4*)(PT + (size_t)r * DM + c) + v * ld_bf16x4(SG + (size_t)r * DM + c)); }
    DEV void operator()(const f32x4 (&acc)[2][2][4][2], const pg8::Unit& u, int wr, int wc, int fr_, int fq_) const { int fr = fr_, fq = fq_; asm volatile("" : "+v"(fr), "+v"(fq));
        EPI_ALL({ apply(r, c, v); }) }
};
struct EpiResid {
    static constexpr bool PERM = false, AFTER_DRAIN = false; const float* xp; const float* xs; float* O;
    DEV void apply(int r, int c, const f32x4 v) const { const float* b = (xs && r >= T) ? xs + (size_t)(r - T) * DM + c : xp + (size_t)r * DM + c; *(f32x4*)(O + (size_t)r * DM + c) = *(const f32x4*)b + v; }
    DEV void operator()(const f32x4 (&acc)[2][2][4][2], const pg8::Unit& u, int wr, int wc, int fr_, int fq_) const { int fr = fr_, fq = fq_; asm volatile("" : "+v"(fr), "+v"(fq));
        EPI_ALL({ apply(r, c, v); }) }
};
struct EpiFinal {
    static constexpr bool PERM = false, AFTER_DRAIN = true; const float* base; float* out; const float* gain; float* xs; unsigned* cnt;
    DEV void operator()(const f32x4 (&)[2][2][4][2], const pg8::Unit&, int, int, int, int) const {}
    DEV void fused(f32x4 (&acc)[2][2][4][2], const pg8::Unit& u, int wr, int wc, int fr_, int fq_, LAS unsigned char* lds, int wid, int lane_) const {
        int fr = fr_, fq = fq_, lane = lane_; asm volatile("" : "+v"(fr), "+v"(fq), "+v"(lane));
        LAS float* P = (LAS float*)lds;
        LAS float* S = (LAS float*)(lds + 8192);
        const int col0 = u.pn * 256 + wc * 32 + 4 * fq;
#pragma unroll
        for (int ai = 0; ai < 2; ++ai)
#pragma unroll
            for (int m = 0; m < 4; ++m) { const int rl = ai * 128 + wr * 64 + m * 16 + fr; const size_t off = (size_t)(u.pm * 256 + rl) * DM + col0; float ss = 0.f;
#pragma unroll
                for (int bj = 0; bj < 2; ++bj)
#pragma unroll
                    for (int n = 0; n < 2; ++n) { const f32x4 x = *(const f32x4*)(base + off + bj * 128 + n * 16) + acc[ai][bj][m][n]; acc[ai][bj][m][n] = x; ss += (x[0] * x[0] + x[1] * x[1]) + (x[2] * x[2] + x[3] * x[3]); }
                ss += __shfl_xor(ss, 16); ss += __shfl_xor(ss, 32);
                if (fq == 0) P[rl * 4 + wc] = ss; }
        asm volatile("s_waitcnt lgkmcnt(0)" ::: "memory"); __builtin_amdgcn_s_barrier(); asm volatile("" ::: "memory");
        const int row = wid * 32 + (lane & 31);
        if (lane < 32) { const float tot = (P[row * 4 + 0] + P[row * 4 + 1]) + (P[row * 4 + 2] + P[row * 4 + 3]);
            __hip_atomic_store(xs + ((size_t)(u.pm * 256 + row) * 4 + u.pn), tot, __ATOMIC_RELAXED, __HIP_MEMORY_SCOPE_AGENT); }
        asm volatile("s_waitcnt vmcnt(0)" ::: "memory");
        if (lane == 0) (void)xb_add(cnt + 64 * u.pm, 1u);
        if (wid == 0) { unsigned sp = 0u;
            while ((unsigned)__builtin_amdgcn_readfirstlane((int)xb_ld(cnt + 64 * u.pm)) < 32u) { __builtin_amdgcn_s_sleep(2); if (++sp > (1u << 22)) break; }
            __builtin_amdgcn_fence(__ATOMIC_ACQUIRE, "agent"); }
        asm volatile("s_waitcnt vmcnt(0) lgkmcnt(0)" ::: "memory"); __builtin_amdgcn_s_barrier(); asm volatile("" ::: "memory");
        if (lane < 32) { const float* sl = xs + (size_t)(u.pm * 256 + row) * 4; float tot = 0.f;
#pragma unroll
            for (int t = 0; t < 4; ++t) tot += __hip_atomic_load(sl + t, __ATOMIC_RELAXED, __HIP_MEMORY_SCOPE_AGENT);
            S[row] = 1.0f / sqrtf(tot * (1.f / DM) + EPS); }
        asm volatile("s_waitcnt lgkmcnt(0)" ::: "memory"); __builtin_amdgcn_s_barrier(); asm volatile("" ::: "memory");
        f32x4 g[2][2];
#pragma unroll
        for (int bj = 0; bj < 2; ++bj)
#pragma unroll
            for (int n = 0; n < 2; ++n) g[bj][n] = *(const f32x4*)(gain + col0 + bj * 128 + n * 16);
#pragma unroll
        for (int ai = 0; ai < 2; ++ai)
#pragma unroll
            for (int m = 0; m < 4; ++m) { const int rl = ai * 128 + wr * 64 + m * 16 + fr; const float rs = S[rl]; const size_t off = (size_t)(u.pm * 256 + rl) * DM + col0;
#pragma unroll
                for (int bj = 0; bj < 2; ++bj)
#pragma unroll
                    for (int n = 0; n < 2; ++n) *(f32x4*)(out + off + bj * 128 + n * 16) = acc[ai][bj][m][n] * rs * g[bj][n]; }
    }
};
template <int K, class Epi> DEV void small_gemm(Frame& F, const bf16* A, const bf16* Bt, const Epi& E) {
    int lane = F.lane; asm volatile("" : "+v"(lane));
    typedef short ab8_ __attribute__((ext_vector_type(8)));
    constexpr int KW = K / 8; static_assert(KW % 32 == 0, "small_gemm K split");
    const int n = lane & 15, q4 = lane >> 4, w = F.wave, tid = F.tid;
    LAS f32x4* part = (LAS f32x4*)F.lds;
    for (int it = F.vcu; it < 256; it += F.G) { const int ct = it >> 2, rg = it & 3;
        const bf16* ap = A + (size_t)(T + 32 * rg + n) * K + w * KW + 8 * q4; const bf16* bp = Bt + (size_t)(16 * ct + n) * K + w * KW + 8 * q4;
        f32x4 acc0 = {0.f, 0.f, 0.f, 0.f}, acc1 = {0.f, 0.f, 0.f, 0.f};
#pragma unroll
        for (int k0 = 0; k0 < KW; k0 += 32) { const ab8_ b = *(const ab8_*)(bp + k0), a0 = *(const ab8_*)(ap + k0), a1 = *(const ab8_*)(ap + (size_t)16 * K + k0);
            acc0 = __builtin_amdgcn_mfma_f32_16x16x32_bf16(b, a0, acc0, 0, 0, 0); acc1 = __builtin_amdgcn_mfma_f32_16x16x32_bf16(b, a1, acc1, 0, 0, 0); }
        part[(w * 2 + 0) * 64 + lane] = acc0; part[(w * 2 + 1) * 64 + lane] = acc1;
        __syncthreads();
        if (tid < 128) { const int mt = tid >> 6; f32x4 sum = part[mt * 64 + lane];
#pragma unroll
            for (int ww = 1; ww < 8; ++ww) sum += part[(ww * 2 + mt) * 64 + lane];
            E.apply(T + 32 * rg + 16 * mt + n, 16 * ct + 4 * q4, sum); }
        __syncthreads();
    }
}
struct EpiFfUp {
    static constexpr bool PERM = true, AFTER_DRAIN = false; bf16* FF;
    DEV void operator()(const f32x4 (&acc)[2][2][4][2], const pg8::Unit& u, int wr, int wc, int fr_, int fq_) const { int fr = fr_, fq = fq_; asm volatile("" : "+v"(fr), "+v"(fq));
        const int f0 = u.pn * 128 + wc * 32 + 8 * fq;
        EPI_ROWS({ if (r < MR) st_bf16x8(FF + (size_t)r * DFF + f0, map_silu(acc[ai][0][m][0]) * acc[ai][1][m][0], map_silu(acc[ai][0][m][1]) * acc[ai][1][m][1]); }) }
};

constexpr int CG_BROW = 144, CG_BUF = 256 * CG_BROW;
DEV void cmp_gemm_unit(Frame& F, int ty, int pm) {
    int lane = F.lane; asm volatile("" : "+v"(lane));
    const int n = lane & 15, q4 = lane >> 4, w = F.wave, tid = F.tid;
    const float* pool = ty ? ((const float*)F.A.in[3]) : ((const float*)F.A.in[2]); const int* ptab = (const int*)F.A.in[9];
    const float* arow[2];
#pragma unroll
    for (int mt = 0; mt < 2; ++mt) { const int r = pm * 256 + 32 * w + 16 * mt + n, b = r >> 11, c = (r >> 1) & 1023, kv = r & 1;
        arow[mt] = pool + (size_t)ptab[b * 128 + (c >> 3)] * 16384 + (size_t)((c & 7) * 16) * 128 + kv * 64 + 8 * q4; }
    const bf16* bsrc = wsp<bf16>(F, ty ? WS_W1V : WS_W1K) + (size_t)(tid >> 1) * 1024 + 32 * (tid & 1);
    LAS unsigned char* bdst = F.lds + (tid >> 1) * CG_BROW + 64 * (tid & 1);
    f32x4 acc[2][16];
#pragma unroll
    for (int mt = 0; mt < 2; ++mt)
#pragma unroll
        for (int nt = 0; nt < 16; ++nt) acc[mt][nt] = (f32x4){0.f, 0.f, 0.f, 0.f};
    f32x4 ar[2][2][2]; v4u br[4];
#define CG_LOAD_A(sl) do { _Pragma("unroll") for (int mt = 0; mt < 2; ++mt) _Pragma("unroll") for (int ks = 0; ks < 2; ++ks) { const float* p_ = arow[mt] + (sl) * 128 + 32 * ks; ar[mt][ks][0] = *(const f32x4*)p_; ar[mt][ks][1] = *(const f32x4*)(p_ + 4); } } while (0)
#define CG_LOAD_B(sl) do { _Pragma("unroll") for (int j = 0; j < 4; ++j) br[j] = *(const v4u*)(bsrc + 64 * (sl) + 8 * j); } while (0)
#define CG_STORE_B(buf) do { _Pragma("unroll") for (int j = 0; j < 4; ++j) *(LAS v4u*)(bdst + (buf) * CG_BUF + 16 * j) = br[j]; } while (0)
    CG_LOAD_A(0); CG_LOAD_B(0); CG_STORE_B(0);
    __syncthreads();
#pragma unroll 1
    for (int sl = 0; sl < 16; ++sl) {
        ab8 af[2][2];
#pragma unroll
        for (int mt = 0; mt < 2; ++mt)
#pragma unroll
            for (int ks = 0; ks < 2; ++ks) { v4u wv; wv.x = pg8::cvt_pk_bf16(ar[mt][ks][0][0], ar[mt][ks][0][1]); wv.y = pg8::cvt_pk_bf16(ar[mt][ks][0][2], ar[mt][ks][0][3]); wv.z = pg8::cvt_pk_bf16(ar[mt][ks][1][0], ar[mt][ks][1][1]); wv.w = pg8::cvt_pk_bf16(ar[mt][ks][1][2], ar[mt][ks][1][3]); af[mt][ks] = __builtin_bit_cast(ab8, wv); }
        if (sl + 1 < 16) { CG_LOAD_A(sl + 1); CG_LOAD_B(sl + 1); }
        const LAS unsigned char* bb = F.lds + (sl & 1) * CG_BUF + n * CG_BROW + 16 * q4;
#pragma unroll
        for (int ks = 0; ks < 2; ++ks)
#pragma unroll
            for (int nt = 0; nt < 16; ++nt) { const ab8 bf = *(const LAS ab8*)(bb + nt * 16 * CG_BROW + 64 * ks);
                acc[0][nt] = __builtin_amdgcn_mfma_f32_16x16x32_bf16(bf, af[0][ks], acc[0][nt], 0, 0, 0); acc[1][nt] = __builtin_amdgcn_mfma_f32_16x16x32_bf16(bf, af[1][ks], acc[1][nt], 0, 0, 0); }
        if (sl + 1 < 16) CG_STORE_B((sl + 1) & 1);
        asm volatile("s_waitcnt lgkmcnt(0)" ::: "memory"); __builtin_amdgcn_s_barrier(); asm volatile("" ::: "memory");
    }
#undef CG_LOAD_A
#undef CG_LOAD_B
#undef CG_STORE_B
    bf16* Tm = wsp<bf16>(F, ty ? WS_TV : WS_TK);
#pragma unroll
    for (int mt = 0; mt < 2; ++mt) { bf16* tp = Tm + (size_t)(pm * 256 + 32 * w + 16 * mt + n) * 256 + 4 * q4;
#pragma unroll
        for (int nt = 0; nt < 16; ++nt) { v2u wv; wv.x = pg8::cvt_pk_bf16(acc[mt][nt][0], acc[mt][nt][1]); wv.y = pg8::cvt_pk_bf16(acc[mt][nt][2], acc[mt][nt][3]); *(v2u*)(tp + 16 * nt) = wv; } }
    __syncthreads();
}

constexpr int HRB = 288;
constexpr int HA_Q = 0, HA_KT = 18432, HA_KP = 36864, HA_KH = 55296, HA_V = 73728, HA_A = 92160, HA_TOT = HA_A + 64 * 144, HA_END = HA_TOT + 2048;
static_assert(HA_END <= RING_BYTES, "hgrn A LDS");
DEV ab8 tr_frag(const LAS unsigned char* base, int row0, int colbyte, int n, int q4, int stride) {
    const LAS unsigned char* p = base + (row0 + 8 * q4 + (n >> 2)) * stride + colbyte + 8 * (n & 3);
    const s16x4 lo = vtr(p), hi = vtr(p + 4 * stride);
    return __builtin_shufflevector(lo, hi, 0, 1, 2, 3, 4, 5, 6, 7);
}
struct HgIn { float z[16]; bf16 q[16], v[16]; float lbv; };
DEV void hgrn_a_load(Frame& F, int c, int h, HgIn& in) {
    const int tid = F.tid, k = tid & 127, tq = tid >> 7;
    const float* HF = wsp<float>(F, WS_HF); const bf16* HQ = wsp<bf16>(F, WS_HQ); const bf16* HI = wsp<bf16>(F, WS_HI);
    const size_t g0 = ((size_t)c * 64 + tq * 16) * 512 + h * 128 + k;
#pragma unroll
    for (int i = 0; i < 16; ++i) { in.z[i] = HF[g0 + (size_t)i * 512]; in.q[i] = HQ[g0 + (size_t)i * 512]; in.v[i] = HI[g0 + (size_t)i * 512]; }
    in.lbv = wsp<float>(F, WS_TBL)[TB_LB + h * 128 + k];
}
DEV void hgrn_a_unit(Frame& F, int c, int h, const HgIn& in) {
    LAS unsigned char* L = F.lds;
    const int tid = F.tid, k = tid & 127, tq = tid >> 7, w = F.wave, lane = F.lane, n = lane & 15, q4 = lane >> 4;
    const float* TB = wsp<float>(F, WS_TBL);
    const float* HF = wsp<float>(F, WS_HF); const bf16* HQ = wsp<bf16>(F, WS_HQ); const bf16* HI = wsp<bf16>(F, WS_HI);
    const float lbv = in.lbv, oml = 1.0f - lbv;
    const size_t row0 = (size_t)c * 64; const int col = h * 128 + k;
    LAS float* TOT = (LAS float*)(L + HA_TOT);
    for (int i = tid; i < 64 * 144 / 4; i += 512) ((LAS unsigned*)(L + HA_A))[i] = 0u;
    float bl[16], kt[16], qt[16]; float run = 0.f;
#pragma unroll
    for (int i = 0; i < 16; ++i) { const int t = tq * 16 + i; const size_t g = (row0 + t) * 512 + col;
        const float z = in.z[i]; const float sg = __builtin_amdgcn_rcpf(1.0f + __expf(-z)), sgm = __builtin_amdgcn_rcpf(1.0f + __expf(z));
        run += __logf(lbv + oml * sg); bl[i] = run; kt[i] = oml * sgm; qt[i] = bf2f(in.q[i]); (void)g;
        *(LAS bf16*)(L + HA_V + t * HRB + 2 * k) = in.v[i]; }
    TOT[tq * 128 + k] = run;
#pragma unroll
    for (int i = 0; i < 16; ++i) { const int t = tq * 16 + i; const float kk = kt[i];
        qt[i] = qt[i] * __expf(bl[i]); kt[i] = kk * __expf(run - bl[i]);
        *(LAS bf16*)(L + HA_Q + t * HRB + 2 * k) = (bf16)f2bf(qt[i]); *(LAS bf16*)(L + HA_KT + t * HRB + 2 * k) = (bf16)f2bf(kt[i]);
        *(LAS bf16*)(L + HA_KP + t * HRB + 2 * k) = (bf16)f2bf(kk * __expf(fminf(-bl[i], 80.f))); }
    __syncthreads();
    { float pf = 0.f, sf = 0.f;
#pragma unroll
      for (int j = 0; j < 4; ++j) { const float tj = TOT[j * 128 + k]; if (j < tq) pf += tj; if (j > tq) sf += tj; }
      const float epf = __expf(pf), esf = __expf(sf);
      bf16* HQT = wsp<bf16>(F, WS_HQT);
#pragma unroll
      for (int i = 0; i < 16; ++i) { const int t = tq * 16 + i; *(LAS bf16*)(L + HA_KH + t * HRB + 2 * k) = (bf16)f2bf(kt[i] * esf); HQT[(row0 + t) * 512 + col] = (bf16)f2bf(qt[i] * epf); }
      if (tq == 3) wsp<float>(F, WS_HD)[(size_t)(c * 4 + h) * 128 + k] = __expf(pf + run); }
    for (int id = w; id < 10; id += 8) {
        int ti, si; if (id < 4) { ti = id; si = id; } else if (id < 7) { si = id - 4; ti = si + 1; } else if (id < 9) { si = id - 7; ti = si + 2; } else { si = 0; ti = 3; }
        const LAS unsigned char* qa = L + HA_Q + (16 * ti + n) * HRB + 16 * q4; const LAS unsigned char* kb = L + (id < 4 ? HA_KP : HA_KT) + (16 * si + n) * HRB + 16 * q4;
        f32x4 acc = {0.f, 0.f, 0.f, 0.f};
#pragma unroll
        for (int ks = 0; ks < 4; ++ks) { ab8 a = *(const LAS ab8*)(qa + 64 * ks); const ab8 b = *(const LAS ab8*)(kb + 64 * ks);
            if (id >= 7) {
                v4u aw = __builtin_bit_cast(v4u, a); float f[8] = {bflo(aw.x), bfhi(aw.x), bflo(aw.y), bfhi(aw.y), bflo(aw.z), bfhi(aw.z), bflo(aw.w), bfhi(aw.w)};
#pragma unroll
                for (int e = 0; e < 8; ++e) { const int kk_ = 32 * ks + 8 * q4 + e; float d = TOT[(si + 1) * 128 + kk_]; if (id == 9) d += TOT[2 * 128 + kk_]; f[e] *= __expf(d); }
                aw.x = cvtpk(f[0], f[1]); aw.y = cvtpk(f[2], f[3]); aw.z = cvtpk(f[4], f[5]); aw.w = cvtpk(f[6], f[7]); a = __builtin_bit_cast(ab8, aw); }
            acc = __builtin_amdgcn_mfma_f32_16x16x32_bf16(a, b, acc, 0, 0, 0); }
#pragma unroll
        for (int i = 0; i < 4; ++i) { const float v = (id < 4 && n > 4 * q4 + i) ? 0.f : acc[i]; *(LAS bf16*)(L + HA_A + (16 * ti + 4 * q4 + i) * 144 + 2 * (16 * si + n)) = (bf16)f2bf(v); }
    }
    __syncthreads();
    { const ab8 v0 = tr_frag(L + HA_V, 0, 32 * w, n, q4, HRB), v1 = tr_frag(L + HA_V, 32, 32 * w, n, q4, HRB);
      float* HIN = wsp<float>(F, WS_HIN) + row0 * 512 + h * 128 + 16 * w + 4 * q4;
#pragma unroll
      for (int ti = 0; ti < 4; ++ti) { const LAS unsigned char* ap = L + HA_A + (16 * ti + n) * 144 + 16 * q4;
          f32x4 acc = {0.f, 0.f, 0.f, 0.f};
          acc = __builtin_amdgcn_mfma_f32_16x16x32_bf16(v0, *(const LAS ab8*)ap, acc, 0, 0, 0);
          if (ti >= 2) acc = __builtin_amdgcn_mfma_f32_16x16x32_bf16(v1, *(const LAS ab8*)(ap + 64), acc, 0, 0, 0);
          *(f32x4*)(HIN + (size_t)(16 * ti + n) * 512) = acc; }
      bf16* HL = wsp<bf16>(F, WS_HL) + (size_t)(c * 4 + h) * 16384 + 16 * w + 4 * q4;
#pragma unroll
      for (int kt_ = 0; kt_ < 8; ++kt_) { const ab8 k0 = tr_frag(L + HA_KH, 0, 32 * kt_, n, q4, HRB), k1 = tr_frag(L + HA_KH, 32, 32 * kt_, n, q4, HRB);
          f32x4 acc = {0.f, 0.f, 0.f, 0.f};
          acc = __builtin_amdgcn_mfma_f32_16x16x32_bf16(v0, k0, acc, 0, 0, 0); acc = __builtin_amdgcn_mfma_f32_16x16x32_bf16(v1, k1, acc, 0, 0, 0);
          v2u wv; wv.x = cvtpk(acc[0], acc[1]); wv.y = cvtpk(acc[2], acc[3]); *(v2u*)(HL + (size_t)(16 * kt_ + n) * 128) = wv; } }
    __syncthreads();
}
DEV void hgrn_sample_unit(Frame& F, int b, int h) {
    LAS float* Lf = (LAS float*)F.lds;
    LAS float* Lkk = Lf + 512;
    LAS float* Lqq = Lkk + 512;
    LAS float* Lo = Lqq + 512;
    LAS float* Lot = Lo + 512;
    const int tid = F.tid, v = tid & 127, kq = tid >> 7;
    const float* TB = wsp<float>(F, WS_TBL);
    const float* HF = wsp<float>(F, WS_HF); const bf16* HQ = wsp<bf16>(F, WS_HQ); const bf16* HI = wsp<bf16>(F, WS_HI);
    { const int k = v, t = kq; const size_t g = (size_t)(T + b * 4 + t) * 512 + h * 128 + k; const float lbv = TB[TB_LB + h * 128 + k], oml = 1.0f - lbv;
      const float z = HF[g]; Lf[t * 128 + k] = lbv + oml * __builtin_amdgcn_rcpf(1.0f + __expf(-z)); Lkk[t * 128 + k] = oml * __builtin_amdgcn_rcpf(1.0f + __expf(z)); Lqq[t * 128 + k] = bf2f(HQ[g]); }
    float S[32];
    const float* S0 = ((const float*)F.A.in[8]) + ((size_t)(b * 4 + h) * 128 + kq * 32) * 128 + v;
#pragma unroll
    for (int j = 0; j < 32; ++j) S[j] = S0[(size_t)j * 128];
    __syncthreads();
    for (int t = 0; t < 4; ++t) {
        const float vt = bf2f(HI[(size_t)(T + b * 4 + t) * 512 + h * 128 + v]);
        float o = 0.f;
#pragma unroll
        for (int j = 0; j < 32; ++j) { const int k = kq * 32 + j; S[j] = Lf[t * 128 + k] * S[j] + Lkk[t * 128 + k] * vt; o += Lqq[t * 128 + k] * S[j]; }
        Lo[kq * 128 + v] = o;
        __syncthreads();
        if (kq == 0) Lot[t * 128 + v] = (Lo[v] + Lo[128 + v]) + (Lo[256 + v] + Lo[384 + v]);
        __syncthreads();
    }
    float* So = F.out + O_SH + ((size_t)(b * 4 + h) * 128 + kq * 32) * 128 + v;
#pragma unroll
    for (int j = 0; j < 32; ++j) So[(size_t)j * 128] = S[j];
    if (F.wave < 4) {
        const int t = F.wave, lane = F.lane; const f32x2 o = *(const LAS f32x2*)(Lot + t * 128 + 2 * lane);
        const float ss = wave_sum(o.x * o.x + o.y * o.y); const float rr = 1.0f / sqrtf(ss * (1.f / 128.f) + EPS);
        const size_t go = (size_t)(T + b * 4 + t) * 512 + h * 128 + 2 * lane; const unsigned gw_ = *(const unsigned*)(wsp<bf16>(F, WS_HG) + go);
        *(unsigned*)(wsp<bf16>(F, WS_OB) + go) = pk2(o.x * rr * ((const float*)F.A.in[20])[2 * lane] * bflo(gw_), o.y * rr * ((const float*)F.A.in[20])[2 * lane + 1] * bfhi(gw_)); }
    __syncthreads();
}
DEV void cmp_prompt_unit(Frame& F, int u) {
    const int ty = u >> 7, kv = (u >> 6) & 1, i0 = (u & 63) * 16, tid = F.tid, w = F.wave;
    int lane = F.lane; asm volatile("" : "+v"(lane));
    const int n = lane & 15, q4 = lane >> 4;
    LAS float* Lg = (LAS float*)F.lds;
    LAS float* w2s = Lg + 16 * 128;
    LAS float* part = w2s + 128 * 64;
    { const float* w2g = ty ? ((const float*)F.A.in[17]) : ((const float*)F.A.in[14]);
#pragma unroll
      for (int j = 0; j < 4; ++j) *(LAS f32x4*)(w2s + 4 * (tid + 512 * j)) = *(const f32x4*)(w2g + 4 * (tid + 512 * j)); }
    const bf16* ap = wsp<bf16>(F, ty ? WS_CVP : WS_CKP) + (size_t)(kv * 1024 + i0 + n) * 1024 + 256 * w + 8 * q4;
    const bf16* bp = wsp<bf16>(F, ty ? WS_W1PV : WS_W1PK) + (size_t)(8 * w) * 512 + lane * 8;
    ab8 af[8];
#pragma unroll
    for (int ks = 0; ks < 8; ++ks) af[ks] = *(const ab8*)(ap + 32 * ks);
#pragma unroll
    for (int ct = 0; ct < 8; ++ct) { f32x4 acc = {0.f, 0.f, 0.f, 0.f};
#pragma unroll
        for (int ks = 0; ks < 8; ++ks) acc = __builtin_amdgcn_mfma_f32_16x16x32_bf16(af[ks], *(const ab8*)(bp + (size_t)(ct * 64 + ks) * 512), acc, 0, 0, 0);
#pragma unroll
        for (int r = 0; r < 4; ++r) part[(w * 16 + 4 * q4 + r) * 128 + 16 * ct + n] = acc[r]; }
    __syncthreads();
    { const float* hb = wsp<float>(F, WS_CTL) + CTL_HB + ty * 128;
#pragma unroll
      for (int j = 0; j < 4; ++j) { const int o = tid + 512 * j; float sum = hb[o & 127];
#pragma unroll
          for (int ww = 0; ww < 8; ++ww) sum += part[ww * 2048 + o];
          Lg[o] = gelu_tanh(sum); } }
    __syncthreads();
#pragma unroll
    for (int j = 0; j < 2; ++j) { const int o = tid + 512 * j, blk = o >> 6, d = o & 63, i = i0 + blk; float s0 = 0.f, s1 = 0.f, s2 = 0.f, s3 = 0.f;
#pragma unroll 8
        for (int e = 0; e < 128; e += 4) { const f32x4 g = *(const LAS f32x4*)(Lg + blk * 128 + e);
            s0 += g[0] * w2s[e * 64 + d]; s1 += g[1] * w2s[(e + 1) * 64 + d]; s2 += g[2] * w2s[(e + 2) * 64 + d]; s3 += g[3] * w2s[(e + 3) * 64 + d]; }
        if (i < NCB) wsp<bf16>(F, ty ? WS_VCP : WS_KCP)[(size_t)(i * 2 + kv) * 64 + d] = (bf16)f2bf((s0 + s1) + (s2 + s3)); }
    __syncthreads();
}
DEV void cmp_sample_task(Frame& F, int tsk) {
    const int ty = tsk >> 12, rem = tsk & 4095, bk = rem >> 6;
    int lane = F.lane; asm volatile("" : "+v"(lane));
    const int n = lane & 15, q4 = lane >> 4, i = (rem & 63) * 16 + n;
    const bool valid = i < NCB;
    const bf16* Tm = wsp<bf16>(F, ty ? WS_TV : WS_TK);
    const float* hb = wsp<float>(F, WS_CTL) + CTL_HB + ty * 128 + 8 * q4;
    const size_t r = ((size_t)(bk >> 1) * 1024 + (valid ? i : 0)) * 2 + (bk & 1);
    const bf16* t0 = Tm + r * 256 + 8 * q4; const bf16* t1 = Tm + (r + 2) * 256 + 128 + 8 * q4;
    const bf16* W2T = wsp<bf16>(F, ty ? WS_W2V : WS_W2K) + (size_t)n * 128 + 8 * q4;
    f32x4 acc[4];
#pragma unroll
    for (int dt = 0; dt < 4; ++dt) acc[dt] = (f32x4){0.f, 0.f, 0.f, 0.f};
#pragma unroll
    for (int ks = 0; ks < 4; ++ks) {
        const v4u a = *(const v4u*)(t0 + 32 * ks), b = *(const v4u*)(t1 + 32 * ks); const f32x4 h0 = *(const f32x4*)(hb + 32 * ks), h1 = *(const f32x4*)(hb + 32 * ks + 4);
        v4u gw; gw.x = cvtpk(gelu_tanh(bflo(a.x) + bflo(b.x) + h0[0]), gelu_tanh(bfhi(a.x) + bfhi(b.x) + h0[1])); gw.y = cvtpk(gelu_tanh(bflo(a.y) + bflo(b.y) + h0[2]), gelu_tanh(bfhi(a.y) + bfhi(b.y) + h0[3]));
        gw.z = cvtpk(gelu_tanh(bflo(a.z) + bflo(b.z) + h1[0]), gelu_tanh(bfhi(a.z) + bfhi(b.z) + h1[1])); gw.w = cvtpk(gelu_tanh(bflo(a.w) + bflo(b.w) + h1[2]), gelu_tanh(bfhi(a.w) + bfhi(b.w) + h1[3]));
        const ab8 gf = __builtin_bit_cast(ab8, gw);
#pragma unroll
        for (int dt = 0; dt < 4; ++dt) acc[dt] = __builtin_amdgcn_mfma_f32_16x16x32_bf16(*(const ab8*)(W2T + (size_t)dt * 16 * 128 + 32 * ks), gf, acc[dt], 0, 0, 0);
    }
    if (valid) { bf16* dst = wsp<bf16>(F, ty ? WS_VCS : WS_KCS) + r * 64 + 4 * q4;
#pragma unroll
        for (int dt = 0; dt < 4; ++dt) { v2u wv; wv.x = cvtpk(acc[dt][0], acc[dt][1]); wv.y = cvtpk(acc[dt][2], acc[dt][3]); *(v2u*)(dst + 16 * dt) = wv; } }
}
DEV void p2_phase(Frame& F) {
    for (int rep = 0; rep < ((PROBE_REP >> 21) & 1) + 1; ++rep) {
        HgIn cur, nxt; if (F.vcu < 1024) hgrn_a_load(F, F.vcu >> 2, F.vcu & 3, cur);
        for (int u = F.vcu; u < 1024; u += F.G) { const int un = u + F.G < 1024 ? u + F.G : u; hgrn_a_load(F, un >> 2, un & 3, nxt); hgrn_a_unit(F, u >> 2, u & 3, cur); cur = nxt; } }
    for (int rep = 0; rep < ((PROBE_REP >> 23) & 1) + 1; ++rep) for (int u = F.vcu; u < 256; u += F.G) cmp_prompt_unit(F, u);
    for (int rep = 0; rep < ((PROBE_REP >> 24) & 1) + 1; ++rep) {
        for (int tsk = F.vcu * 8 + F.wave; tsk < 8192; tsk += F.G * 8) cmp_sample_task(F, tsk); }
    __syncthreads();
}

DEV void hgrn_scan(Frame& F) {
    if (F.vcu >= 64) return;
    const int e2 = F.vcu * 512 + F.tid, e = 2 * e2, h = e >> 14, k = (e >> 7) & 127;
    unsigned* HL = (unsigned*)wsp<bf16>(F, WS_HL) + e2; const float* HD = wsp<float>(F, WS_HD) + h * 128 + k;
    float s0 = 0.f, s1 = 0.f;
#pragma unroll 1
    for (int c0 = 0; c0 < 256; c0 += 32) {
        unsigned Lv[32]; float dv[32];
#pragma unroll
        for (int j = 0; j < 32; ++j) { Lv[j] = HL[(size_t)(c0 + j) * 32768]; dv[j] = HD[(c0 + j) * 512]; }
#pragma unroll
        for (int j = 0; j < 32; ++j) { HL[(size_t)(c0 + j) * 32768] = pk2(s0, s1); s0 = dv[j] * s0 + bflo(Lv[j]); s1 = dv[j] * s1 + bfhi(Lv[j]); }
    }
    *(f32x2*)(F.out + O_PH + e) = (f32x2){s0, s1};
}


constexpr int TROW = 128, TILEB = 64 * TROW;
DEV int swz(int row, int chunk) { return row * TROW + ((chunk ^ (row & 7)) << 4); }
constexpr int SCS = 260;
constexpr int SEL_SLOTS = 6;
constexpr int DMA_SLOTS_C = 3;
constexpr int AT_SC = DMA_SLOTS_C * 2 * TILEB;
constexpr int AT_MSK = AT_SC + 64 * SCS * 4;
constexpr int DMA_SLOTS_W = AT_MSK / (2 * TILEB) < 6 ? AT_MSK / (2 * TILEB) : 6;
constexpr int AT_LST = AT_MSK + 2064;
constexpr int AT_LUT = AT_LST + 1056;
constexpr int AT_END = AT_LUT + 8 * 129 * 4;
static_assert(AT_END <= RING_BYTES && AT_SC % 16 == 0 && AT_MSK % 16 == 0 && AT_LST % 16 == 0 && SEL_SLOTS * 2 * TILEB <= AT_MSK && DMA_SLOTS_W >= 3, "attention unit LDS");
constexpr float QSCALE = 0.125f * LOG2E;


struct AttnCtx {
    const LAS float* lut;
    int n, q4, h;
    int tq[2];
    float b31;
};
DEV void qk64(const LAS unsigned char* Kb, const AttnCtx& C, const ab8 (&qf)[2][2], f32x4 (&s)[2][4], float init0, float init1, bool a0, bool a1) {
    ab8 k0[4], k1[4];
#pragma unroll
    for (int kt = 0; kt < 4; ++kt) { k0[kt] = *(const LAS ab8*)(Kb + swz(16 * kt + C.n, C.q4)); k1[kt] = *(const LAS ab8*)(Kb + swz(16 * kt + C.n, 4 + C.q4)); }
    __builtin_amdgcn_sched_barrier(0);
#pragma unroll
    for (int kt = 0; kt < 4; ++kt) {
        if (a0) { f32x4 c = {init0, init0, init0, init0}; c = __builtin_amdgcn_mfma_f32_16x16x32_bf16(k0[kt], qf[0][0], c, 0, 0, 0); s[0][kt] = __builtin_amdgcn_mfma_f32_16x16x32_bf16(k1[kt], qf[0][1], c, 0, 0, 0); }
        if (a1) { f32x4 c = {init1, init1, init1, init1}; c = __builtin_amdgcn_mfma_f32_16x16x32_bf16(k0[kt], qf[1][0], c, 0, 0, 0); s[1][kt] = __builtin_amdgcn_mfma_f32_16x16x32_bf16(k1[kt], qf[1][1], c, 0, 0, 0); }
    }
}
template <bool LUTB, bool WINLO>
DEV void mask_bias(f32x4 (&s)[4], const AttnCtx& C, int t, int p0, int pstep, bool colok) {
#pragma unroll
    for (int kt = 0; kt < 4; ++kt)
#pragma unroll
        for (int i = 0; i < 4; ++i) { const int rel = t - (p0 + pstep * (16 * kt + 4 * C.q4 + i));
            bool ok = colok && rel >= 0; if (WINLO) ok = ok && rel < 512;
            float v = s[kt][i]; if (LUTB) v += C.lut[C.h * 129 + (rel < 0 ? 0 : (rel < 128 ? rel : 128))];
            s[kt][i] = ok ? v : NEG_INF; }
}
DEV float colmax16(const f32x4 (&s)[4]) {
    float mx = fmaxf(fmaxf(s[0][0], s[0][1]), fmaxf(s[0][2], s[0][3]));
#pragma unroll
    for (int kt = 1; kt < 4; ++kt) mx = fmaxf(mx, fmaxf(fmaxf(s[kt][0], s[kt][1]), fmaxf(s[kt][2], s[kt][3])));
    mx = fmaxf(mx, __shfl_xor(mx, 16)); mx = fmaxf(mx, __shfl_xor(mx, 32));
    return mx;
}
DEV void online_step(f32x4 (&s)[4], float& m, float& l, f32x4 (&O)[4], ab8 (&pf)[2]) {
    const float mx = colmax16(s), mn = fmaxf(m, mx), ms = (mn == NEG_INF) ? 0.f : mn;
    const float sc = __builtin_amdgcn_exp2f(m - ms);
    float ps = 0.f;
#pragma unroll
    for (int kt = 0; kt < 4; ++kt)
#pragma unroll
        for (int i = 0; i < 4; ++i) { const float p = __builtin_amdgcn_exp2f(s[kt][i] - ms); s[kt][i] = p; ps += p; }
    l = l * sc + ps; m = mn;
#pragma unroll
    for (int dt = 0; dt < 4; ++dt) O[dt] = O[dt] * sc;
#pragma unroll
    for (int j = 0; j < 2; ++j) { v4u w; w.x = cvtpk(s[2 * j][0], s[2 * j][1]); w.y = cvtpk(s[2 * j][2], s[2 * j][3]); w.z = cvtpk(s[2 * j + 1][0], s[2 * j + 1][1]); w.w = cvtpk(s[2 * j + 1][2], s[2 * j + 1][3]); pf[j] = __builtin_bit_cast(ab8, w); }
}
DEV void ref_step(f32x4 (&s)[4], float& m, f32x4 (&O)[4], f32x4& L, ab8 (&pf)[2], bool colact) {
    float mx = fmaxf(fmaxf(s[0][0], s[0][1]), fmaxf(s[0][2], s[0][3]));
#pragma unroll
    for (int kt = 1; kt < 4; ++kt) mx = fmaxf(mx, fmaxf(fmaxf(s[kt][0], s[kt][1]), fmaxf(s[kt][2], s[kt][3])));
    const bool slow = (colact && m == NEG_INF) || mx > 64.f;
    if (__any(slow)) {
        mx = fmaxf(mx, __shfl_xor(mx, 16)); mx = fmaxf(mx, __shfl_xor(mx, 32));
        const bool un = (m == NEG_INF);
        const float d = (mx == NEG_INF) ? 0.f : (un ? mx : fmaxf(mx, 0.f));
        const float sc = un ? 1.f : __builtin_amdgcn_exp2f(-d);
#pragma unroll
        for (int kt = 0; kt < 4; ++kt) s[kt] = s[kt] - d;
#pragma unroll
        for (int dt = 0; dt < 4; ++dt) O[dt] = O[dt] * sc;
        L = L * sc;
        m = un ? ((mx == NEG_INF) ? NEG_INF : mx) : m + d;
    }
#pragma unroll
    for (int kt = 0; kt < 4; ++kt)
#pragma unroll
        for (int i = 0; i < 4; ++i) s[kt][i] = __builtin_amdgcn_exp2f(s[kt][i]);
#pragma unroll
    for (int j = 0; j < 2; ++j) { v4u w; w.x = cvtpk(s[2 * j][0], s[2 * j][1]); w.y = cvtpk(s[2 * j][2], s[2 * j][3]); w.z = cvtpk(s[2 * j + 1][0], s[2 * j + 1][1]); w.w = cvtpk(s[2 * j + 1][2], s[2 * j + 1][3]); pf[j] = __builtin_bit_cast(ab8, w); }
}
DEV float cinit(float bias, float m, bool colact) { return colact ? bias - ((m == NEG_INF) ? 0.f : m) : NEG_INF; }
template <bool PV, bool WITHL>
DEV void pv64(const LAS unsigned char* Vb, const AttnCtx& C, const ab8 (&pf)[2][2], f32x4 (&O)[2][4], f32x4 (&L)[2], bool a0, bool a1) {
    if (PV) {
        const int vr = 4 * C.q4 + (C.n >> 2), vc = (C.n & 3) >> 1, vs = 8 * (C.n & 1);
        ab8 vf[4][2];
#pragma unroll
        for (int dt = 0; dt < 4; ++dt)
#pragma unroll
            for (int j = 0; j < 2; ++j) {
                const s16x4 lo = vtr(Vb + swz(32 * j + vr, 2 * dt + vc) + vs), hi = vtr(Vb + swz(32 * j + 16 + vr, 2 * dt + vc) + vs);
                vf[dt][j] = __builtin_shufflevector(lo, hi, 0, 1, 2, 3, 4, 5, 6, 7); }
        __builtin_amdgcn_sched_barrier(0);
#pragma unroll
        for (int dt = 0; dt < 4; ++dt)
#pragma unroll
            for (int j = 0; j < 2; ++j) {
                if (a0) O[0][dt] = __builtin_amdgcn_mfma_f32_16x16x32_bf16(vf[dt][j], pf[0][j], O[0][dt], 0, 0, 0);
                if (a1) O[1][dt] = __builtin_amdgcn_mfma_f32_16x16x32_bf16(vf[dt][j], pf[1][j], O[1][dt], 0, 0, 0); }
    }
    if (WITHL) {
        const short one = (C.n == 0) ? (short)0x3F80 : (short)0; const ab8 ones = {one, one, one, one, one, one, one, one};
#pragma unroll
        for (int j = 0; j < 2; ++j) {
            if (a0) L[0] = __builtin_amdgcn_mfma_f32_16x16x32_bf16(ones, pf[0][j], L[0], 0, 0, 0);
            if (a1) L[1] = __builtin_amdgcn_mfma_f32_16x16x32_bf16(ones, pf[1][j], L[1], 0, 0, 0);
        }
    }
}
DEV void pv_load(const LAS unsigned char* Vb, const AttnCtx& C, ab8 (&vf)[4][2]) {
    const int vr = 4 * C.q4 + (C.n >> 2), vc = (C.n & 3) >> 1, vs = 8 * (C.n & 1);
#pragma unroll
    for (int dt = 0; dt < 4; ++dt)
#pragma unroll
        for (int j = 0; j < 2; ++j) {
            const s16x4 lo = vtr(Vb + swz(32 * j + vr, 2 * dt + vc) + vs), hi = vtr(Vb + swz(32 * j + 16 + vr, 2 * dt + vc) + vs);
            vf[dt][j] = __builtin_shufflevector(lo, hi, 0, 1, 2, 3, 4, 5, 6, 7); }
}
DEV void pv_mma(const AttnCtx& C, const ab8 (&vf)[4][2], const ab8 (&pf)[2][2], f32x4 (&O)[2][4], f32x4 (&L)[2], bool a0, bool a1) {
#pragma unroll
    for (int dt = 0; dt < 4; ++dt)
#pragma unroll
        for (int j = 0; j < 2; ++j) {
            if (a0) O[0][dt] = __builtin_amdgcn_mfma_f32_16x16x32_bf16(vf[dt][j], pf[0][j], O[0][dt], 0, 0, 0);
            if (a1) O[1][dt] = __builtin_amdgcn_mfma_f32_16x16x32_bf16(vf[dt][j], pf[1][j], O[1][dt], 0, 0, 0); }
    const short one = (C.n == 0) ? (short)0x3F80 : (short)0; const ab8 ones = {one, one, one, one, one, one, one, one};
#pragma unroll
    for (int j = 0; j < 2; ++j) {
        if (a0) L[0] = __builtin_amdgcn_mfma_f32_16x16x32_bf16(ones, pf[0][j], L[0], 0, 0, 0);
        if (a1) L[1] = __builtin_amdgcn_mfma_f32_16x16x32_bf16(ones, pf[1][j], L[1], 0, 0, 0); }
}
DEV void tile_issue(const bf16* Kg, const bf16* Vg, int row0, int tid, v4u& rk, v4u& rv, bool withV) {
    const size_t off = (size_t)(row0 + (tid >> 3)) * 128 + (tid & 7) * 8;
    rk = *(const v4u*)(Kg + off); if (withV) rv = *(const v4u*)(Vg + off);
}
DEV void tile_commit(LAS unsigned char* buf, int tid, const v4u rk, const v4u rv, bool withV) {
    LAS unsigned char* d = buf + swz(tid >> 3, tid & 7);
    *(LAS v4u*)d = rk; if (withV) *(LAS v4u*)(d + TILEB) = rv;
}
template <class RowFn, class Compute>
DEV void stream_tiles(Frame& F, int n, const bf16* Kg, const bf16* Vg, bool withV, RowFn rowfn, Compute compute) {
    if (n <= 0) return;
    v4u rk, rv = {0u, 0u, 0u, 0u};
    tile_issue(Kg, Vg, rowfn(0), F.tid, rk, rv, withV); tile_commit(F.lds, F.tid, rk, rv, withV);
    __syncthreads();
    for (int i = 0; i < n; ++i) {
        LAS unsigned char* cur = F.lds + (i & 1) * 2 * TILEB; LAS unsigned char* nxt = F.lds + ((i + 1) & 1) * 2 * TILEB;
        const bool more = i + 1 < n;
        if (more) tile_issue(Kg, Vg, rowfn(i + 1), F.tid, rk, rv, withV);
        compute(i, cur, cur + TILEB);
        if (more) tile_commit(nxt, F.tid, rk, rv, withV);
        __syncthreads();
    }
}
template <int S, bool WITHV, class RowFn, class Compute>
DEV void stream_tiles_dma(Frame& F, int n, const bf16* Kg, const bf16* Vg, RowFn rowfn, Compute compute) {
    if (n <= 0) return;
    int tid = F.tid; asm volatile("" : "+v"(tid));
    const unsigned goff = (unsigned)((tid >> 3) * 256 + (((tid & 7) ^ ((tid >> 3) & 7)) << 4));
    LAS unsigned char* lbase = F.lds + F.wave * 1024;
    constexpr int L = WITHV ? 2 : 1;
#define SD_ISSUE(t) do { const int t_ = (t); LAS unsigned char* d_ = lbase + (t_ % S) * 2 * TILEB; const size_t gb_ = (size_t)rowfn(t_) * 256 + goff; \
        __builtin_amdgcn_global_load_lds((const unsigned*)((const char*)Kg + gb_), (LAS unsigned*)d_, 16, 0, 0); \
        if (WITHV) __builtin_amdgcn_global_load_lds((const unsigned*)((const char*)Vg + gb_), (LAS unsigned*)(d_ + TILEB), 16, 0, 0); } while (0)
    for (int t = 0; t < S - 1 && t < n; ++t) SD_ISSUE(t);
    for (int i = 0; i < n; ++i) {
        const int ahead = (n - 1 - i) < (S - 2) ? (n - 1 - i) : (S - 2);
        static_assert(S >= 2 && S <= 6, "stream_tiles_dma slots");
        if (ahead * L >= 8) asm volatile("s_waitcnt vmcnt(8)" ::: "memory"); else if (ahead * L == 6) asm volatile("s_waitcnt vmcnt(6)" ::: "memory");
        else if (ahead * L == 4) asm volatile("s_waitcnt vmcnt(4)" ::: "memory"); else if (ahead * L == 3) asm volatile("s_waitcnt vmcnt(3)" ::: "memory");
        else if (ahead * L == 2) asm volatile("s_waitcnt vmcnt(2)" ::: "memory"); else if (ahead * L == 1) asm volatile("s_waitcnt vmcnt(1)" ::: "memory");
        else asm volatile("s_waitcnt vmcnt(0)" ::: "memory");
        __builtin_amdgcn_s_barrier(); asm volatile("" ::: "memory");
        if (i + S - 1 < n) SD_ISSUE(i + S - 1);
        const LAS unsigned char* cur = F.lds + (i % S) * 2 * TILEB;
        compute(i, cur, cur + TILEB);
    }
#undef SD_ISSUE
    asm volatile("" ::: "memory"); __builtin_amdgcn_s_barrier(); asm volatile("" ::: "memory");
}
template <int NB, class RowFn, class Compute>
DEV void stream_stages_dma(Frame& F, int n, const bf16* Kg, const bf16* Vg, RowFn rowfn, Compute compute) {
    if (n <= 0) return;
    int tid = F.tid; asm volatile("" : "+v"(tid));
    const unsigned goff = (unsigned)((tid >> 3) * 256 + (((tid & 7) ^ ((tid >> 3) & 7)) << 4));
    LAS unsigned char* lbase = F.lds + F.wave * 1024;
#define SS_ISSUE(t, slot) do { LAS unsigned char* d_ = lbase + (slot) * 2 * TILEB; const size_t gb_ = (size_t)rowfn(t) * 256 + goff; \
        __builtin_amdgcn_global_load_lds((const unsigned*)((const char*)Kg + gb_), (LAS unsigned*)d_, 16, 0, 0); \
        __builtin_amdgcn_global_load_lds((const unsigned*)((const char*)Vg + gb_), (LAS unsigned*)(d_ + TILEB), 16, 0, 0); } while (0)
#pragma unroll
    for (int b = 0; b < NB; ++b) if (b < n) SS_ISSUE(b, b);
    for (int i0 = 0, st = 0; i0 < n; i0 += NB, st ^= 1) {
        asm volatile("s_waitcnt vmcnt(0)" ::: "memory");
        __builtin_amdgcn_s_barrier(); asm volatile("" ::: "memory");
#pragma unroll
        for (int b = 0; b < NB; ++b) if (i0 + NB + b < n) SS_ISSUE(i0 + NB + b, (st ^ 1) * NB + b);
        const LAS unsigned char* cur = F.lds + st * NB * 2 * TILEB;
#pragma unroll
        for (int b = 0; b < NB; ++b) if (i0 + b < n) compute(i0 + b, cur + b * 2 * TILEB, cur + b * 2 * TILEB + TILEB);
    }
#undef SS_ISSUE
    asm volatile("" ::: "memory"); __builtin_amdgcn_s_barrier(); asm volatile("" ::: "memory");
}
template <int NB, class RowFn, class Compute>
DEV void stream_tiles_multi(Frame& F, int n, const bf16* Kg, const bf16* Vg, RowFn rowfn, Compute compute) {
    if (n <= 0) return;
    v4u rk[NB], rv[NB];
#pragma unroll
    for (int b = 0; b < NB; ++b) if (b < n) { tile_issue(Kg, Vg, rowfn(b), F.tid, rk[b], rv[b], true); }
#pragma unroll
    for (int b = 0; b < NB; ++b) if (b < n) tile_commit(F.lds + b * 2 * TILEB, F.tid, rk[b], rv[b], true);
    __syncthreads();
    for (int i0 = 0, st = 0; i0 < n; i0 += NB, st ^= 1) {
        LAS unsigned char* cur = F.lds + st * NB * 2 * TILEB; LAS unsigned char* nxt = F.lds + (st ^ 1) * NB * 2 * TILEB;
#pragma unroll
        for (int b = 0; b < NB; ++b) if (i0 + NB + b < n) tile_issue(Kg, Vg, rowfn(i0 + NB + b), F.tid, rk[b], rv[b], true);
#pragma unroll
        for (int b = 0; b < NB; ++b) if (i0 + b < n) compute(i0 + b, cur + b * 2 * TILEB, cur + b * 2 * TILEB + TILEB);
#pragma unroll
        for (int b = 0; b < NB; ++b) if (i0 + NB + b < n) tile_commit(nxt + b * 2 * TILEB, F.tid, rk[b], rv[b], true);
        __syncthreads();
    }
}
template <int CTRL> DEV unsigned dpp_u32(unsigned v) { return (unsigned)__builtin_amdgcn_update_dpp(0, (int)v, CTRL, 0xF, 0xF, false); }
DEV unsigned wave_max_u32(unsigned v) {
    v = max(v, dpp_u32<0x128>(v)); v = max(v, dpp_u32<0x124>(v)); v = max(v, dpp_u32<0x122>(v)); v = max(v, dpp_u32<0x121>(v));
    v = max(v, (unsigned)__shfl_xor((int)v, 16)); v = max(v, (unsigned)__shfl_xor((int)v, 32));
    return v;
}
template <int NQ>
DEV void select_queries(const LAS float* score, int cur, int q0, LAS unsigned* msk, int lane) {
    unsigned key[NQ][4];
#pragma unroll
    for (int ql = 0; ql < NQ; ++ql)
#pragma unroll
        for (int mm = 0; mm < 4; ++mm) { const int j = lane + 64 * mm; key[ql][mm] = (j >= 1 && j <= cur - 2) ? ((__float_as_uint(score[(q0 + ql) * SCS + j]) & 0xFFFFFF00u) | (unsigned)(255 - j)) : 0u; }
    const int ns = cur >= 2 ? 3 : cur + 1;
    const int ncand = cur - 2 > 0 ? cur - 2 : 0;
    if (lane == 0) {
#pragma unroll
        for (int ql = 0; ql < NQ; ++ql) { const int q = q0 + ql; const unsigned bit = 1u << (q & 31); LAS unsigned* mw = msk + (q >> 5);
            __hip_atomic_fetch_or(mw, bit, __ATOMIC_RELAXED, __HIP_MEMORY_SCOPE_WORKGROUP);
            if (cur >= 1) __hip_atomic_fetch_or(mw + 2 * cur, bit, __ATOMIC_RELAXED, __HIP_MEMORY_SCOPE_WORKGROUP);
            if (cur >= 2) __hip_atomic_fetch_or(mw + 2 * (cur - 1), bit, __ATOMIC_RELAXED, __HIP_MEMORY_SCOPE_WORKGROUP); }
    }
    if (ncand <= 16 - ns) {
        if (lane < ncand) {
#pragma unroll
            for (int ql = 0; ql < NQ; ++ql) { const int q = q0 + ql; __hip_atomic_fetch_or(msk + (q >> 5) + 2 * (1 + lane), 1u << (q & 31), __ATOMIC_RELAXED, __HIP_MEMORY_SCOPE_WORKGROUP); } }
        return;
    }
    for (int it = ns; it < 16; ++it) {
        unsigned best[NQ];
#pragma unroll
        for (int ql = 0; ql < NQ; ++ql) best[ql] = max(max(key[ql][0], key[ql][1]), max(key[ql][2], key[ql][3]));
#pragma unroll
        for (int ql = 0; ql < NQ; ++ql) best[ql] = wave_max_u32(best[ql]);
#pragma unroll
        for (int ql = 0; ql < NQ; ++ql) {
#pragma unroll
            for (int mm = 0; mm < 4; ++mm) key[ql][mm] = (key[ql][mm] == best[ql]) ? 0u : key[ql][mm];
            if (lane == 0) { const int q = q0 + ql, jw = 255 - (int)(best[ql] & 0xFFu); __hip_atomic_fetch_or(msk + (q >> 5) + 2 * jw, 1u << (q & 31), __ATOMIC_RELAXED, __HIP_MEMORY_SCOPE_WORKGROUP); } }
    }
}

DEV void attn_unit_mfma(Frame& F, int qg, int kv) {
    int lane = F.lane; asm volatile("" : "+v"(lane));
    const int w = F.wave, tid = F.tid, t0 = qg * 64, cur = qg;
    AttnCtx C; C.n = lane & 15; C.q4 = lane >> 4; C.h = C.n & 3;
    C.lut = (const LAS float*)(F.lds + AT_LUT) + kv * 4 * 129;
    C.tq[0] = t0 + 8 * w + (C.n >> 2); C.tq[1] = C.tq[0] + 4;
    C.b31 = C.lut[C.h * 129 + 128];
    LAS float* score = (LAS float*)(F.lds + AT_SC); LAS unsigned* msk = (LAS unsigned*)(F.lds + AT_MSK); LAS int* lst = (LAS int*)(F.lds + AT_LST);
    ab8 qf[2][2];
    { const bf16* QA = wsp<bf16>(F, WS_QA) + (size_t)(kv * 4 + C.h) * 64 + 8 * C.q4;
#pragma unroll
      for (int g = 0; g < 2; ++g)
#pragma unroll
          for (int ks = 0; ks < 2; ++ks) qf[g][ks] = *(const ab8*)(QA + (size_t)C.tq[g] * 512 + 32 * ks); }
    for (int i = tid; i < 64 * SCS; i += 512) score[i] = 0.f;
    for (int i = tid; i < 516; i += 512) msk[i] = 0u;
    float* ACC = wsp<float>(F, WS_PT);
    const float* GA = wsp<float>(F, WS_GA);
    float m[2]; f32x4 O[2][4], L[2];
#define RESET_STATE() do { _Pragma("unroll") for (int g = 0; g < 2; ++g) { m[g] = NEG_INF; L[g] = (f32x4){0.f, 0.f, 0.f, 0.f}; _Pragma("unroll") for (int dt = 0; dt < 4; ++dt) O[g][dt] = (f32x4){0.f, 0.f, 0.f, 0.f}; } } while (0)
#define ACC_AT(g, dt) (ACC + (size_t)C.tq[g] * 512 + (kv * 4 + C.h) * 64 + 16 * (dt) + 4 * C.q4)
#define FOLD_BRANCH(br) do { _Pragma("unroll") for (int g = 0; g < 2; ++g) { const float lt = __shfl(L[g][0], C.n); \
        const float gsc = (lt > 0.f) ? GA[(size_t)C.tq[g] * 24 + (kv * 4 + C.h) * 3 + (br)] / lt : 0.f; _Pragma("unroll") for (int dt = 0; dt < 4; ++dt) { f32x4* ap_ = (f32x4*)ACC_AT(g, dt); *ap_ = *ap_ + O[g][dt] * gsc; } } } while (0)

    const bf16* KC = wsp<bf16>(F, WS_KCP) + kv * 64; const bf16* VC = wsp<bf16>(F, WS_VCP) + kv * 64;
    const int nblk = 4 * cur + 3, ntc = (nblk + 63) >> 6;
    RESET_STATE();
    for (int rep_ = 0; rep_ < ((PROBE_REP >> 16) & 1) + 1; ++rep_) { RESET_STATE();
    stream_tiles_dma<DMA_SLOTS_C, false>(F, ntc, KC, VC, [&](int i) { return 64 * i; }, [&](int i, const LAS unsigned char* Kb, const LAS unsigned char* Vb) {
        const bool near = t0 - (1024 * i + 1039) < 128; const float bi = near ? 0.f : C.b31;
        f32x4 s[2][4]; qk64(Kb, C, qf, s, cinit(bi, m[0], true), cinit(bi, m[1], true), true, true);
        ab8 pf[2][2];
#pragma unroll
        for (int g = 0; g < 2; ++g) { if (near) mask_bias<true, false>(s[g], C, C.tq[g], 1024 * i + 31, 16, true);
            ref_step(s[g], m[g], O[g], L[g], pf[g], true); }
        pv64<false, true>(Vb, C, pf, O, L, true, true);
    });
    }
    float invl[2];
#pragma unroll
    for (int g = 0; g < 2; ++g) { const float lt = __shfl(L[g][0], C.n); invl[g] = lt > 0.f ? 1.0f / lt : 0.f; }
    stream_tiles_dma<DMA_SLOTS_C, true>(F, ntc, KC, VC, [&](int i) { return 64 * i; }, [&](int i, const LAS unsigned char* Kb, const LAS unsigned char* Vb) {
        const bool near = t0 - (1024 * i + 1039) < 128; const float bi = near ? 0.f : C.b31;
        f32x4 s[2][4]; qk64(Kb, C, qf, s, cinit(bi, m[0], true), cinit(bi, m[1], true), true, true);
        ab8 pf[2][2];
#pragma unroll
        for (int g = 0; g < 2; ++g) { if (near) mask_bias<true, false>(s[g], C, C.tq[g], 1024 * i + 31, 16, true);
#pragma unroll
            for (int kt = 0; kt < 4; ++kt) {
#pragma unroll
                for (int ii = 0; ii < 4; ++ii) s[g][kt][ii] = __builtin_amdgcn_exp2f(s[g][kt][ii]) * invl[g];
                float i0 = s[g][kt][0], i1 = s[g][kt][1], i2 = s[g][kt][2], i3 = s[g][kt][3];
                i0 += dpp_xor1(i0); i0 += dpp_xor2(i0); i1 += dpp_xor1(i1); i1 += dpp_xor2(i1); i2 += dpp_xor1(i2); i2 += dpp_xor2(i2); i3 += dpp_xor1(i3); i3 += dpp_xor2(i3);
                if (C.h == 0) { const int J = 16 * i + 4 * kt + C.q4; LAS float* sr = score + (8 * w + 4 * g + (C.n >> 2)) * SCS + J;
                    __hip_atomic_fetch_add(sr, 2.f * (i0 + i1 + i2) + i3, __ATOMIC_RELAXED, __HIP_MEMORY_SCOPE_WORKGROUP); __hip_atomic_fetch_add(sr + 1, i3, __ATOMIC_RELAXED, __HIP_MEMORY_SCOPE_WORKGROUP); } }
#pragma unroll
            for (int j = 0; j < 2; ++j) { v4u wv; wv.x = cvtpk(s[g][2 * j][0], s[g][2 * j][1]); wv.y = cvtpk(s[g][2 * j][2], s[g][2 * j][3]); wv.z = cvtpk(s[g][2 * j + 1][0], s[g][2 * j + 1][1]); wv.w = cvtpk(s[g][2 * j + 1][2], s[g][2 * j + 1][3]); pf[g][j] = __builtin_bit_cast(ab8, wv); } }
        pv64<true, false>(Vb, C, pf, O, L, true, true);
    });
#pragma unroll
    for (int g = 0; g < 2; ++g) { const float gsc = GA[(size_t)C.tq[g] * 24 + (kv * 4 + C.h) * 3 + 0];
#pragma unroll
        for (int dt = 0; dt < 4; ++dt) *(f32x4*)ACC_AT(g, dt) = O[g][dt] * gsc; }
    __syncthreads();
    for (int rep_ = 0; rep_ < ((PROBE_REP >> 19) & 1) + 1; ++rep_) select_queries<8>(score, cur, 8 * w, msk, lane);
    __syncthreads();
    if (w == 0) {
        int base = 0;
        for (int mm = 0; mm < 5; ++mm) { const int j = 64 * mm + lane; const bool has = (j <= cur) && ((msk[2 * (j < 258 ? j : 0)] | msk[2 * (j < 258 ? j : 0) + 1]) != 0u);
            const unsigned long long b = __ballot(has); const int pre = __popcll(b & ((1ull << lane) - 1ull));
            if (has) lst[1 + base + pre] = j; base += __popcll(b); }
        if (lane == 0) lst[0] = base;
    }
    __syncthreads();
    const int nbl = __builtin_amdgcn_readfirstlane(lst[0]);
    RESET_STATE();
    if (PROBE_REP & (1 << 20)) stream_tiles_multi<3>(F, nbl, wsp<bf16>(F, WS_KS) + kv * 64, wsp<bf16>(F, WS_VS) + kv * 64, [&](int i) { return 64 * lst[1 + i]; }, [&](int i, const LAS unsigned char* Kb, const LAS unsigned char* Vb) { (void)i; (void)Kb; (void)Vb; });
    for (int rep_ = 0; rep_ < ((PROBE_REP >> 18) & 1) + 1; ++rep_) { RESET_STATE();
    stream_stages_dma<3>(F, nbl, wsp<bf16>(F, WS_KS) + kv * 64, wsp<bf16>(F, WS_VS) + kv * 64, [&](int i) { return 64 * lst[1 + i]; }, [&](int i, const LAS unsigned char* Kb, const LAS unsigned char* Vb) {
        const int j = lst[1 + i]; const unsigned byte = (msk[2 * j + (w >> 2)] >> (8 * (w & 3))) & 0xffu;
        const bool a0 = (byte & 0xfu) != 0u, a1 = (byte & 0xf0u) != 0u;
        if (a0 || a1) {
            const bool near = j >= cur - 2; const float bi = near ? 0.f : C.b31;
            const bool c0 = ((byte >> (C.n >> 2)) & 1u) != 0u, c1 = ((byte >> (4 + (C.n >> 2))) & 1u) != 0u;
#define SEL_BODY(A0, A1) do { f32x4 s[2][4]; qk64(Kb, C, qf, s, cinit(bi, m[0], c0), cinit(bi, m[1], c1), A0, A1); ab8 pf[2][2]; \
                if (A0) { if (near) mask_bias<true, false>(s[0], C, C.tq[0], 64 * j, 1, true); ref_step(s[0], m[0], O[0], L[0], pf[0], c0); } \
                if (A1) { if (near) mask_bias<true, false>(s[1], C, C.tq[1], 64 * j, 1, true); ref_step(s[1], m[1], O[1], L[1], pf[1], c1); } \
                pv64<true, true>(Vb, C, pf, O, L, A0, A1); } while (0)
            if (a0 && a1) SEL_BODY(true, true); else if (a0) SEL_BODY(true, false); else SEL_BODY(false, true);
#undef SEL_BODY
        }
    });
    }
    FOLD_BRANCH(1);
    const int iw0 = (t0 >= 512) ? 0 : (512 - t0) >> 6;
    RESET_STATE();
    for (int rep_ = 0; rep_ < ((PROBE_REP >> 17) & 1) + 1; ++rep_) { RESET_STATE();
    stream_tiles_dma<DMA_SLOTS_W, true>(F, 9 - iw0, wsp<bf16>(F, WS_KW) + kv * 64, wsp<bf16>(F, WS_VW) + kv * 64, [&](int i) { return t0 - 512 + 64 * (i + iw0); }, [&](int i, const LAS unsigned char* Kb, const LAS unsigned char* Vb) {
        const int it = i + iw0, p0 = t0 - 512 + 64 * it; const bool near = it >= 6; const float bi = near ? 0.f : C.b31;
        f32x4 s[2][4]; qk64(Kb, C, qf, s, cinit(bi, m[0], true), cinit(bi, m[1], true), true, true);
        ab8 pf[2][2], vf[4][2]; pv_load(Vb, C, vf); __builtin_amdgcn_sched_barrier(0);
#pragma unroll
        for (int g = 0; g < 2; ++g) { if (near) mask_bias<true, false>(s[g], C, C.tq[g], p0, 1, true); else if (it == 0) mask_bias<false, true>(s[g], C, C.tq[g], p0, 1, true);
            ref_step(s[g], m[g], O[g], L[g], pf[g], true); }
        pv_mma(C, vf, pf, O, L, true, true);
    });
    }
    bf16* OA = wsp<bf16>(F, WS_OA);
#pragma unroll
    for (int g = 0; g < 2; ++g) { const float lt = __shfl(L[g][0], C.n); const float gsc = (lt > 0.f) ? GA[(size_t)C.tq[g] * 24 + (kv * 4 + C.h) * 3 + 2] / lt : 0.f;
#pragma unroll
        for (int dt = 0; dt < 4; ++dt) { const f32x4 o = *(const f32x4*)ACC_AT(g, dt) + O[g][dt] * gsc; v2u wv; wv.x = cvtpk(o[0], o[1]); wv.y = cvtpk(o[2], o[3]); *(v2u*)(OA + (size_t)C.tq[g] * 512 + (kv * 4 + C.h) * 64 + 16 * dt + 4 * C.q4) = wv; } }
#undef ACC_AT
#undef RESET_STATE
#undef FOLD_BRANCH
    __syncthreads();
}

constexpr int SU_V = 0;
constexpr int SU_COMB = 8 * TILEB;
constexpr int SU_SC = AT_END;
constexpr int SU_MSK = SU_SC + 4 * SCS * 4;
constexpr int SU_LST = SU_MSK + 2064;
constexpr int SU_SEL = SU_LST + 1056;
constexpr int SU_END = SU_SEL + 256;
static_assert(SU_COMB + 8 * 18 * 64 * 4 <= AT_LUT && SU_END <= RING_BYTES && SU_SC % 16 == 0, "sample unit LDS");

template <bool F32> DEV ab8 ld_kfrag(const char* rowp, int ks, int q4) {
    if (rowp == nullptr) return (ab8){0, 0, 0, 0, 0, 0, 0, 0};
    if (F32) { const f32x4 a = *(const f32x4*)(rowp + (32 * ks + 8 * q4) * 4), b = *(const f32x4*)(rowp + (32 * ks + 8 * q4) * 4 + 16);
        v4u w; w.x = cvtpk(a[0], a[1]); w.y = cvtpk(a[2], a[3]); w.z = cvtpk(b[0], b[1]); w.w = cvtpk(b[2], b[3]); return __builtin_bit_cast(ab8, w); }
    return *(const ab8*)(rowp + (32 * ks + 8 * q4) * 2);
}
template <class Src> DEV void qk64_src(const Src& S, const AttnCtx& C, const ab8 (&qf)[2][2], f32x4 (&s)[4], float init) {
    ab8 kf[4][2];
    int n_ = C.n, q4_ = C.q4; asm volatile("" : "+v"(n_), "+v"(q4_));
#pragma unroll
    for (int kt = 0; kt < 4; ++kt) { const char* rp = S.krow(16 * kt + n_); kf[kt][0] = ld_kfrag<Src::F32>(rp, 0, q4_); kf[kt][1] = ld_kfrag<Src::F32>(rp, 1, q4_); }
#pragma unroll
    for (int kt = 0; kt < 4; ++kt) { f32x4 c = {init, init, init, init}; c = __builtin_amdgcn_mfma_f32_16x16x32_bf16(kf[kt][0], qf[0][0], c, 0, 0, 0); s[kt] = __builtin_amdgcn_mfma_f32_16x16x32_bf16(kf[kt][1], qf[0][1], c, 0, 0, 0); }
}
template <class Src> DEV void stage_v(const Src& S, LAS unsigned char* Vb, int lane) {
    asm volatile("" : "+v"(lane) :: "memory");
    const char* rp = S.vrow(lane); LAS unsigned char* d = Vb + lane * TROW; const int sx = lane & 7;
    if (Src::F32) {
#pragma unroll
        for (int hh = 0; hh < 2; ++hh) {
            f32x4 v[8];
#pragma unroll
            for (int j = 0; j < 8; ++j) v[j] = rp ? *(const f32x4*)(rp + 128 * hh + 16 * j) : (f32x4){0.f, 0.f, 0.f, 0.f};
#pragma unroll
            for (int j = 0; j < 4; ++j) { v4u w; w.x = cvtpk(v[2 * j][0], v[2 * j][1]); w.y = cvtpk(v[2 * j][2], v[2 * j][3]); w.z = cvtpk(v[2 * j + 1][0], v[2 * j + 1][1]); w.w = cvtpk(v[2 * j + 1][2], v[2 * j + 1][3]); *(LAS v4u*)(d + (((4 * hh + j) ^ sx) << 4)) = w; }
            asm volatile("" ::: "memory");
        }
    } else {
        v4u v[8];
#pragma unroll
        for (int j = 0; j < 8; ++j) v[j] = rp ? *(const v4u*)(rp + 16 * j) : (v4u){0u, 0u, 0u, 0u};
#pragma unroll
        for (int j = 0; j < 8; ++j) *(LAS v4u*)(d + ((j ^ sx) << 4)) = v[j];
    }
    LDS_WAIT();
}
struct SCmpSrc { static constexpr bool F32 = false; const bf16 *K, *V; int blk0;
    DEV const char* krow(int kk) const { return (const char*)(K + (size_t)(blk0 + kk) * 128); }
    DEV const char* vrow(int kk) const { return (const char*)(V + (size_t)(blk0 + kk) * 128); } };
struct SSelSrc { static constexpr bool F32 = true; const float *K, *V, *Kn, *Vn; int j;
    DEV const char* krow(int kk) const { return j < 256 ? (const char*)(K + (size_t)kk * 128) : (kk < 4 ? (const char*)(Kn + kk * 128) : nullptr); }
    DEV const char* vrow(int kk) const { return j < 256 ? (const char*)(V + (size_t)kk * 128) : (kk < 4 ? (const char*)(Vn + kk * 128) : nullptr); } };
struct SWinSrc { static constexpr bool F32 = true; const float *K, *V; int nrows;
    DEV const char* krow(int kk) const { return kk < nrows ? (const char*)(K + (size_t)kk * 128) : nullptr; }
    DEV const char* vrow(int kk) const { return kk < nrows ? (const char*)(V + (size_t)kk * 128) : nullptr; } };

DEV void su_publish(LAS float* comb, int w, int lane, float m, float l, const f32x4 (&O)[4]) {
    LAS float* c = comb + w * 18 * 64 + lane; c[0] = m; c[64] = l;
#pragma unroll
    for (int dt = 0; dt < 4; ++dt)
#pragma unroll
        for (int i = 0; i < 4; ++i) c[(2 + 4 * dt + i) * 64] = O[dt][i];
}
DEV void su_combine(const LAS float* comb, int lane, float& l, f32x4 (&O)[4], bool withO) {
    float ms = NEG_INF;
#pragma unroll
    for (int w = 0; w < 8; ++w) ms = fmaxf(ms, comb[w * 18 * 64 + lane]);
    if (ms == NEG_INF) ms = 0.f;
    l = 0.f;
#pragma unroll
    for (int dt = 0; dt < 4; ++dt) O[dt] = (f32x4){0.f, 0.f, 0.f, 0.f};
#pragma unroll 1
    for (int w = 0; w < 8; ++w) { const LAS float* c = comb + w * 18 * 64 + lane; const float wg = __builtin_amdgcn_exp2f(c[0] - ms); l += c[64] * wg;
        if (withO) {
#pragma unroll
            for (int dt = 0; dt < 4; ++dt)
#pragma unroll
                for (int i = 0; i < 4; ++i) O[dt][i] += c[(2 + 4 * dt + i) * 64] * wg; } }
    l += __shfl_xor(l, 16); l += __shfl_xor(l, 32);
}

DEV void attn_unit_sample(Frame& F, int b, int kv) {
    int lane = F.lane; asm volatile("" : "+v"(lane));
    const int w = F.wave, tid = F.tid;
    AttnCtx C; C.n = lane & 15; C.q4 = lane >> 4; C.h = C.n & 3;
    C.lut = (const LAS float*)(F.lds + AT_LUT) + kv * 4 * 129;
    C.tq[0] = T + (C.n >> 2); C.tq[1] = C.tq[0];
    C.b31 = C.lut[C.h * 129 + 128];
    const int r = T + b * 4 + (C.n >> 2);
    LAS unsigned char* Vw = F.lds + SU_V + w * TILEB; LAS float* comb = (LAS float*)(F.lds + SU_COMB);
    LAS float* score = (LAS float*)(F.lds + SU_SC); LAS unsigned* msk = (LAS unsigned*)(F.lds + SU_MSK); LAS int* lst = (LAS int*)(F.lds + SU_LST);
    ab8 qf[2][2];
    { const bf16* QA = wsp<bf16>(F, WS_QA) + (size_t)r * 512 + (kv * 4 + C.h) * 64 + 8 * C.q4; qf[0][0] = *(const ab8*)QA; qf[0][1] = *(const ab8*)(QA + 32); qf[1][0] = qf[0][0]; qf[1][1] = qf[0][1]; }
    for (int i = tid; i < 4 * SCS; i += 512) score[i] = 0.f;
    for (int i = tid; i < 516; i += 512) msk[i] = 0u;
    const float* GA = wsp<float>(F, WS_GA) + (size_t)r * 24 + (kv * 4 + C.h) * 3;
    f32x4 OF[4], O[2][4], Ldum[2]; float m, l;
#pragma unroll
    for (int dt = 0; dt < 4; ++dt) OF[dt] = (f32x4){0.f, 0.f, 0.f, 0.f};
#define SU_RESET() do { m = NEG_INF; l = 0.f; _Pragma("unroll") for (int dt = 0; dt < 4; ++dt) O[0][dt] = (f32x4){0.f, 0.f, 0.f, 0.f}; } while (0)
    __syncthreads();
    const bf16* KC = wsp<bf16>(F, WS_KCS) + (size_t)b * 1024 * 128 + kv * 64; const bf16* VC = wsp<bf16>(F, WS_VCS) + (size_t)b * 1024 * 128 + kv * 64;
    SU_RESET();
#pragma unroll 1
    for (int ti = 2 * w; ti < 2 * w + 2; ++ti) {
        const bool near = ti == 15; SCmpSrc S{KC, VC, 64 * ti};
        f32x4 s[4]; qk64_src(S, C, qf, s, near ? 0.f : C.b31);
        if (near) mask_bias<true, false>(s, C, C.tq[0], 1024 * ti + 31, 16, true);
        const float mx = colmax16(s), mn = fmaxf(m, mx), ms = (mn == NEG_INF) ? 0.f : mn; float ps = 0.f;
#pragma unroll
        for (int kt = 0; kt < 4; ++kt)
#pragma unroll
            for (int ii = 0; ii < 4; ++ii) ps += __builtin_amdgcn_exp2f(s[kt][ii] - ms);
        l = l * __builtin_amdgcn_exp2f(m - ms) + ps; m = mn;
    }
    su_publish(comb, w, lane, m, l, O[0]);
    __syncthreads();
    float mfin = NEG_INF, invl;
    { f32x4 dummy[4]; float lt;
#pragma unroll
      for (int ww = 0; ww < 8; ++ww) mfin = fmaxf(mfin, comb[ww * 18 * 64 + lane]);
      su_combine(comb, lane, lt, dummy, false); invl = lt > 0.f ? 1.0f / lt : 0.f; if (mfin == NEG_INF) mfin = 0.f; }
    __syncthreads();
    SU_RESET();
#pragma unroll 1
    for (int ti = 2 * w; ti < 2 * w + 2; ++ti) {
        const bool near = ti == 15; SCmpSrc S{KC, VC, 64 * ti};
        f32x4 s[4]; qk64_src(S, C, qf, s, near ? 0.f : C.b31);
        if (near) mask_bias<true, false>(s, C, C.tq[0], 1024 * ti + 31, 16, true);
        stage_v(S, Vw, lane);
        ab8 pf[2][2];
#pragma unroll
        for (int kt = 0; kt < 4; ++kt) {
#pragma unroll
            for (int ii = 0; ii < 4; ++ii) s[kt][ii] = __builtin_amdgcn_exp2f(s[kt][ii] - mfin) * invl;
            float i0 = s[kt][0], i1 = s[kt][1], i2 = s[kt][2], i3 = s[kt][3];
            i0 += dpp_xor1(i0); i0 += dpp_xor2(i0); i1 += dpp_xor1(i1); i1 += dpp_xor2(i1); i2 += dpp_xor1(i2); i2 += dpp_xor2(i2); i3 += dpp_xor1(i3); i3 += dpp_xor2(i3);
            if (C.h == 0) { const int J = 16 * ti + 4 * kt + C.q4; LAS float* sr = score + (C.n >> 2) * SCS + J;
                __hip_atomic_fetch_add(sr, 2.f * (i0 + i1 + i2) + i3, __ATOMIC_RELAXED, __HIP_MEMORY_SCOPE_WORKGROUP); __hip_atomic_fetch_add(sr + 1, i3, __ATOMIC_RELAXED, __HIP_MEMORY_SCOPE_WORKGROUP); } }
#pragma unroll
        for (int j = 0; j < 2; ++j) { v4u wv; wv.x = cvtpk(s[2 * j][0], s[2 * j][1]); wv.y = cvtpk(s[2 * j][2], s[2 * j][3]); wv.z = cvtpk(s[2 * j + 1][0], s[2 * j + 1][1]); wv.w = cvtpk(s[2 * j + 1][2], s[2 * j + 1][3]); pf[0][j] = __builtin_bit_cast(ab8, wv); }
        pv64<true, false>(Vw, C, pf, O, Ldum, true, false);
    }
    su_publish(comb, w, lane, 0.f, 0.f, O[0]);
    __syncthreads();
    { float lt; f32x4 Oc[4]; su_combine(comb, lane, lt, Oc, true); const float g0 = GA[0];
#pragma unroll
      for (int dt = 0; dt < 4; ++dt) OF[dt] += Oc[dt] * g0; }
    if (w == 0) select_queries<4>(score, 256, 0, msk, lane);
    __syncthreads();
    if (w == 0) {
        int base = 0;
        for (int mm = 0; mm < 5; ++mm) { const int j = 64 * mm + lane; const bool has = (j <= 256) && (msk[2 * (j < 258 ? j : 0)] != 0u);
            const unsigned long long bb = __ballot(has); const int pre = __popcll(bb & ((1ull << lane) - 1ull));
            if (has) lst[1 + base + pre] = j; base += __popcll(bb); }
        if (lane == 0) lst[0] = base;
    }
    __syncthreads();
    const int nbl = lst[0];
    const int* pt = ((const int*)F.A.in[9]) + b * 128;
    SU_RESET();
#pragma unroll 1
    for (int idx = w; idx < nbl; idx += 8) {
        const int j = lst[1 + idx]; const unsigned nib = msk[2 * j] & 0xfu;
        const size_t pg = (j < 256) ? ((size_t)pt[j >> 1] * 16384 + (size_t)((j & 1) * 64) * 128) : 0;
        SSelSrc S{((const float*)F.A.in[4]) + pg + kv * 64, ((const float*)F.A.in[5]) + pg + kv * 64, F.out + O_SKS + (size_t)b * 4 * 128 + kv * 64, F.out + O_SVS + (size_t)b * 4 * 128 + kv * 64, j};
        const bool near = j >= 254; const bool colok = ((nib >> (C.n >> 2)) & 1u) != 0u;
        f32x4 s[4]; qk64_src(S, C, qf, s, near ? 0.f : C.b31);
        if (near) mask_bias<true, false>(s, C, C.tq[0], 64 * j, 1, colok); else mask_bias<false, false>(s, C, C.tq[0], 64 * j, 1, colok);
        stage_v(S, Vw, lane);
        ab8 pf[2][2]; online_step(s, m, l, O[0], pf[0]);
        pv64<true, false>(Vw, C, pf, O, Ldum, true, false);
    }
    su_publish(comb, w, lane, m, l, O[0]);
    __syncthreads();
    { float lt; f32x4 Os[4]; su_combine(comb, lane, lt, Os, true); const float g1 = lt > 0.f ? GA[1] / lt : 0.f;
#pragma unroll
      for (int dt = 0; dt < 4; ++dt) OF[dt] += Os[dt] * g1; }
    __syncthreads();
    SU_RESET();
#pragma unroll 1
    for (int ti = w; ti < 9; ti += 8) {
        const bool nw = ti == 8;
        SWinSrc S{nw ? F.out + O_SKW + (size_t)(b * 512 + 508) * 128 + kv * 64 : ((const float*)F.A.in[6]) + (size_t)(b * 512 + 64 * ti) * 128 + kv * 64,
                  nw ? F.out + O_SVW + (size_t)(b * 512 + 508) * 128 + kv * 64 : ((const float*)F.A.in[7]) + (size_t)(b * 512 + 64 * ti) * 128 + kv * 64, nw ? 4 : 64};
        const bool near = ti >= 6; const int p0 = T - 512 + 64 * ti;
        f32x4 s[4]; qk64_src(S, C, qf, s, near ? 0.f : C.b31);
        if (near) mask_bias<true, false>(s, C, C.tq[0], p0, 1, true); else if (ti == 0) mask_bias<false, true>(s, C, C.tq[0], p0, 1, true);
        stage_v(S, Vw, lane);
        ab8 pf[2][2]; online_step(s, m, l, O[0], pf[0]);
        pv64<true, false>(Vw, C, pf, O, Ldum, true, false);
    }
    su_publish(comb, w, lane, m, l, O[0]);
    __syncthreads();
    if (w == 0) { float lt; f32x4 Ow[4]; su_combine(comb, lane, lt, Ow, true); const float g2 = lt > 0.f ? GA[2] / lt : 0.f;
        bf16* OA = wsp<bf16>(F, WS_OA) + (size_t)r * 512 + (kv * 4 + C.h) * 64 + 4 * C.q4;
#pragma unroll
        for (int dt = 0; dt < 4; ++dt) { const f32x4 o = OF[dt] + Ow[dt] * g2; v2u wv; wv.x = cvtpk(o[0], o[1]); wv.y = cvtpk(o[2], o[3]); *(v2u*)(OA + 16 * dt) = wv; } }
#undef SU_RESET
    __syncthreads();
}
DEV void hgrn_c_unit(Frame& F, int c, int hp);
DEV void p3_phase(Frame& F, bool do_scan, int qoff) {
    { const float* TB = wsp<float>(F, WS_TBL) + TB_BIAS; LAS float* biasL = (LAS float*)(F.lds + LDSBIAS_OFF); LAS float* lut2 = (LAS float*)(F.lds + AT_LUT);
      for (int i = F.tid; i < 8 * 129; i += 512) { const float b = TB[i]; biasL[i] = b; lut2[i] = b * LOG2E; } }
    __syncthreads();
    unsigned* scan_done = (unsigned*)(F.ws + WS_CTL) + CTL_Q + 384;
    if (do_scan) { hgrn_scan(F);
        if (F.vcu < 64) { asm volatile("s_waitcnt vmcnt(0)" ::: "memory"); __syncthreads(); if (F.tid == 0) { __builtin_amdgcn_fence(__ATOMIC_RELEASE, "agent"); (void)xb_add(scan_done, 1u); } } }
    {
        LAS int* qslot = (LAS int*)(F.lds + LDSCTL_OFF + 32); unsigned* qctr = (unsigned*)(F.ws + WS_CTL) + CTL_Q + qoff;
        const int k0 = (int)(xb_xcc_id() & 1u);
        for (int pass = 0; pass < 2; ++pass) { const int kq = k0 ^ pass;
            for (;;) {
                if (F.tid == 0) *qslot = (int)atomicAdd(qctr + 64 * kq, 1u);
                __syncthreads();
                const int item = *qslot;
                __syncthreads();
                if (item >= 288) break;
                if (item < 32) attn_unit_sample(F, item, kq); else attn_unit_mfma(F, 255 - (item - 32), kq);
            }
        }
    }
    {
        LAS int* qslot = (LAS int*)(F.lds + LDSCTL_OFF + 32); unsigned* hctr = (unsigned*)(F.ws + WS_CTL) + CTL_Q + 320 + (qoff ? 32 : 0);
        for (;;) {
            if (F.tid == 0) *qslot = (int)atomicAdd(hctr, 1u);
            __syncthreads();
            const int item = *qslot;
            __syncthreads();
            if (item >= 128) break;
            hgrn_sample_unit(F, item >> 2, item & 3);
        }
    }
    {
        LAS int* qslot = (LAS int*)(F.lds + LDSCTL_OFF + 32); unsigned* cctr = (unsigned*)(F.ws + WS_CTL) + CTL_Q + 448 + (qoff ? 32 : 0);
        bool ready = false;
        for (;;) {
            if (F.tid == 0) *qslot = (int)atomicAdd(cctr, 1u);
            __syncthreads();
            const int item = *qslot;
            __syncthreads();
            if (item >= 512) break;
            if (!ready) {
                if (F.tid == 0) { unsigned sp = 0u; while (xb_ld(scan_done) < 64u) { __builtin_amdgcn_s_sleep(2); if (++sp > (1u << 22)) break; }
                    __builtin_amdgcn_fence(__ATOMIC_ACQUIRE, "agent"); asm volatile("s_waitcnt vmcnt(0)" ::: "memory"); }
                __syncthreads(); ready = true;
            }
            hgrn_c_unit(F, item >> 1, item & 1);
        }
    }
    if (PROBE_REP & 4096) for (int u = F.vcu; u < 512; u += F.G) { const int qg = u < 256 ? u : 511 - u, kv = u < 256 ? 0 : 1; attn_unit_mfma(F, qg, kv); }
    __syncthreads();
    if (PROBE_REP & 8192) for (int u = F.vcu; u < 2 * DEC_B; u += F.G) attn_unit_sample(F, u >> 1, u & 1);
    __syncthreads();
}

constexpr int HC_SROW = 288;
DEV void hgrn_c_unit(Frame& F, int c, int hp) {
    LAS unsigned char* L = F.lds;
    const int tid = F.tid, w = F.wave, lane = F.lane, n = lane & 15, q4 = lane >> 4;
    { const bf16* HL = wsp<bf16>(F, WS_HL) + (size_t)(c * 4 + 2 * hp) * 16384;
#pragma unroll
      for (int j = 0; j < 8; ++j) { const int e8 = tid + 512 * j; const v4u v = *(const v4u*)(HL + 8 * e8); const int hh = e8 >> 11, rem = e8 & 2047, kr = rem >> 4, vc = (rem & 15) * 8;
          *(LAS v4u*)(L + hh * 128 * HC_SROW + kr * HC_SROW + 2 * vc) = v; } }
    __syncthreads();
    const int h = 2 * hp + (w >> 2), ti = w & 3; const size_t row = (size_t)c * 64 + 16 * ti + n;
    const LAS unsigned char* Sb = L + (w >> 2) * 128 * HC_SROW;
    const bf16* qp = wsp<bf16>(F, WS_HQT) + row * 512 + h * 128 + 8 * q4;
    f32x4 acc[8];
#pragma unroll
    for (int vt = 0; vt < 8; ++vt) acc[vt] = *(const f32x4*)(wsp<float>(F, WS_HIN) + row * 512 + h * 128 + 16 * vt + 4 * q4);
#pragma unroll
    for (int ks = 0; ks < 4; ++ks) { const ab8 qf = *(const ab8*)(qp + 32 * ks);
#pragma unroll
        for (int vt = 0; vt < 8; ++vt) { const ab8 sf = tr_frag(Sb, 32 * ks, 32 * vt, n, q4, HC_SROW); acc[vt] = __builtin_amdgcn_mfma_f32_16x16x32_bf16(sf, qf, acc[vt], 0, 0, 0); } }
    float ss = 0.f;
#pragma unroll
    for (int vt = 0; vt < 8; ++vt) ss += (acc[vt][0] * acc[vt][0] + acc[vt][1] * acc[vt][1]) + (acc[vt][2] * acc[vt][2] + acc[vt][3] * acc[vt][3]);
    ss += __shfl_xor(ss, 16); ss += __shfl_xor(ss, 32);
    const float rr = 1.0f / sqrtf(ss * (1.f / 128.f) + EPS);
    const bf16* HG = wsp<bf16>(F, WS_HG) + row * 512 + h * 128 + 4 * q4; bf16* OB = wsp<bf16>(F, WS_OB) + row * 512 + h * 128 + 4 * q4; const float* gn = ((const float*)F.A.in[20]) + 4 * q4;
#pragma unroll
    for (int vt = 0; vt < 8; ++vt) { const v2u gw_ = *(const v2u*)(HG + 16 * vt); const f32x4 g4 = *(const f32x4*)(gn + 16 * vt);
        v2u wv; wv.x = cvtpk(acc[vt][0] * rr * g4[0] * bflo(gw_.x), acc[vt][1] * rr * g4[1] * bfhi(gw_.x)); wv.y = cvtpk(acc[vt][2] * rr * g4[2] * bflo(gw_.y), acc[vt][3] * rr * g4[3] * bfhi(gw_.y));
        *(v2u*)(OB + 16 * vt) = wv; }
    __syncthreads();
}
DEV void p4_phase(Frame& F) {
    const float* HO = wsp<float>(F, WS_HO);
    for (int it = F.vcu * 8 + F.wave; it < NSMP * 4; it += F.G * 8) { const int rs = it >> 2, h = it & 3; const size_t g = (size_t)rs * 512 + h * 128 + 2 * F.lane;
        const f32x2 o = *(const f32x2*)(HO + g); const float ss = wave_sum(o.x * o.x + o.y * o.y); const float rr = 1.0f / sqrtf(ss * (1.f / 128.f) + EPS);
        const size_t go = (size_t)(T + rs) * 512 + h * 128 + 2 * F.lane; const unsigned gw_ = *(const unsigned*)(wsp<bf16>(F, WS_HG) + go);
        *(unsigned*)(wsp<bf16>(F, WS_OB) + go) = pk2(o.x * rr * ((const float*)F.A.in[20])[2 * F.lane] * bflo(gw_), o.y * rr * ((const float*)F.A.in[20])[2 * F.lane + 1] * bfhi(gw_)); }
}

constexpr int NPHASE = 12;

__global__ void __launch_bounds__(512, 2) mk_fwd(Args args) {
    extern __shared__ __attribute__((aligned(16))) unsigned char lds[];
    Frame F{args};
    F.lds = (LAS unsigned char*)lds; F.tid = threadIdx.x; F.lane = F.tid & 63; F.wave = __builtin_amdgcn_readfirstlane(F.tid >> 6);
    F.G = gridDim.x; { const int bx = blockIdx.x; F.vcu = (F.G % 8 == 0) ? (bx % 8) * (F.G / 8) + bx / 8 : bx; }
    F.out = args.out; F.ws = args.ws;
    for (int u = F.tid; u < 16; u += 512) ((LAS unsigned*)(F.lds + LDSCTL_OFF))[u] = 0u;
    __syncthreads();
    const int lo = args.ph_lo, hi = args.ph_hi;
    XcdBarrier bar; bar.bar = (unsigned*)(F.ws + WS_CTL) + 4096; bar.x = 0; bar.st = (volatile LAS unsigned*)(F.lds + LDSCTL_OFF);
    if (hi - lo > 1) bar = xcd_barrier_post((unsigned*)(F.ws + WS_CTL) + 4096, (volatile LAS unsigned*)(F.lds + LDSCTL_OFF));
#define IN(k) (lo <= (k) && (k) < hi)
#define PHASE_BEGIN() do { int t_ = threadIdx.x; asm volatile("" : "+v"(t_)); F.tid = t_; F.lane = t_ & 63; F.wave = __builtin_amdgcn_readfirstlane(t_ >> 6); } while (0)
#define SEAM(k) do { if (IN(k) && IN((k) + 1)) xcd_barrier(bar); } while (0)
    const int cid = (int)blockIdx.x;

    if (IN(0)) { PHASE_BEGIN(); p0_prologue(F, true); if (PROBE_REP & 1) { __syncthreads(); p0_prologue(F, false); } } SEAM(0);
    if (IN(1)) {
        SchedOne S{(const char*)(F.ws + WS_XN), (const char*)(F.ws + WS_WIN), MP / 256, NIN / 256, 1024, F.G, cid};
        EpiP1 E{F.out, wsp<bf16>(F, WS_QA), wsp<bf16>(F, WS_KS), wsp<bf16>(F, WS_VS), wsp<bf16>(F, WS_KW), wsp<bf16>(F, WS_VW), wsp<bf16>(F, WS_CKP), wsp<bf16>(F, WS_CVP), wsp<bf16>(F, WS_HQ), wsp<bf16>(F, WS_HI),
                wsp<bf16>(F, WS_HG), wsp<bf16>(F, WS_SGA), wsp<bf16>(F, WS_SGB), wsp<bf16>(F, WS_TK), wsp<bf16>(F, WS_TV), wsp<float>(F, WS_HF), wsp<float>(F, WS_GA)};
        pg8::gemm_phase<EpiP1, SchedOne, true, true>(F.lds, 1024, S, E);
        if (PROBE_REP & (1 << 1)) {pg8::gemm_phase<EpiP1, SchedOne, true, true>(F.lds, 1024, S, E); }
        PHASE_BEGIN();
        { LAS float* scr = (LAS float*)(F.lds + F.wave * 16384);
          const int rem = P1_U0 % F.G, first = rem ? rem : 0, nw = (F.G - first) * 8;
          if (cid >= first) for (int d = (cid - first) * 8 + F.wave; d < DEF_N; d += nw) { if (d < DEF_NTR) tr_dispatch(F, DEF_I0 + d, scr, F.lane); else win_copy_item(F, d - DEF_NTR, F.lane); }
          __syncthreads(); }
        for (int rep = 0; rep < ((PROBE_REP >> 14) & 1) + 1; ++rep)
        for (int u = F.G - 1 - F.vcu; u < 512; u += F.G) cmp_gemm_unit(F, u >> 8, u & 255);
    } SEAM(1);
    if (IN(2)) { PHASE_BEGIN(); p2_phase(F); if (PROBE_REP & 4) { __syncthreads(); p2_phase(F); } } SEAM(2);
    if (IN(3)) { PHASE_BEGIN(); p3_phase(F, true, 0); if (PROBE_REP & 8) { __syncthreads(); p3_phase(F, false, 128); } } SEAM(3);
    if (IN(5)) {
        SchedOne S{(const char*)(F.ws + WS_OA), (const char*)(F.ws + WS_WPA), T / 256, 4, 512, F.G, cid};
        EpiProjA E{wsp<bf16>(F, WS_SGA), wsp<float>(F, WS_PT)};
        PHASE_BEGIN(); small_gemm<512>(F, wsp<bf16>(F, WS_OA), wsp<bf16>(F, WS_WPA), E);
        pg8::gemm_phase<EpiProjA, SchedOne, true, true>(F.lds, 512, S, E);
        if (PROBE_REP & (1 << 5)) {pg8::gemm_phase<EpiProjA, SchedOne, true, true>(F.lds, 512, S, E); }
    } if (IN(5) && IN(6)) { asm volatile("s_waitcnt vmcnt(0)" ::: "memory"); __syncthreads(); }
    if (IN(6)) {
        SchedOne S{(const char*)(F.ws + WS_OB), (const char*)(F.ws + WS_WPB), T / 256, 4, 512, F.G, cid};
        EpiProjB E{wsp<bf16>(F, WS_SGB), wsp<float>(F, WS_PT), wsp<bf16>(F, WS_MG)};
        PHASE_BEGIN(); small_gemm<512>(F, wsp<bf16>(F, WS_OB), wsp<bf16>(F, WS_WPB), E);
        pg8::gemm_phase<EpiProjB, SchedOne, true, true>(F.lds, 512, S, E);
        if (PROBE_REP & (1 << 6)) {pg8::gemm_phase<EpiProjB, SchedOne, true, true>(F.lds, 512, S, E); }
    } SEAM(6);
    if (IN(7)) {
        SchedOne S{(const char*)(F.ws + WS_MG), (const char*)(F.ws + WS_WO), T / 256, 4, 1024, F.G, cid};
        EpiResid E{((const float*)F.A.in[0]), ((const float*)F.A.in[1]), wsp<float>(F, WS_X1)};
        PHASE_BEGIN(); small_gemm<1024>(F, wsp<bf16>(F, WS_MG), wsp<bf16>(F, WS_WO), E);
        pg8::gemm_phase<EpiResid, SchedOne, true, true>(F.lds, 1024, S, E);
        if (PROBE_REP & (1 << 7)) {pg8::gemm_phase<EpiResid, SchedOne, true, true>(F.lds, 1024, S, E); }
    } SEAM(7);
    if (IN(8)) { PHASE_BEGIN();
        const int gw = F.vcu * 8 + F.wave, NGW = F.G * 8;
        for (int rep = 0; rep < ((PROBE_REP >> 8) & 1) + 1; ++rep)
        { const float* X1 = wsp<float>(F, WS_X1); bf16* XN = wsp<bf16>(F, WS_XN); rms_rows<false>(gw, NGW, MR, [&](int m) { return X1 + (size_t)m * DM; }, [&](int m) { return XN + (size_t)m * DM; }, ((const float*)F.A.in[24]), F.lane); }
    } SEAM(8);
    if (IN(9)) {
        SchedOne S{(const char*)(F.ws + WS_XN), (const char*)(F.ws + WS_WGU), MP / 256, NGU / 256, 1024, F.G, cid};
        EpiFfUp E{wsp<bf16>(F, WS_FF)};
        pg8::gemm_phase<EpiFfUp, SchedOne, true, true>(F.lds, 1024, S, E);
        if (PROBE_REP & (1 << 9)) {pg8::gemm_phase<EpiFfUp, SchedOne, true, true>(F.lds, 1024, S, E); }
    } SEAM(9);
    if (IN(10)) {
        SchedOne S{(const char*)(F.ws + WS_FF), (const char*)(F.ws + WS_WD), T / 256, 4, DFF, F.G, cid};
        EpiResid Es{wsp<float>(F, WS_X1), nullptr, wsp<float>(F, WS_PT)};
        PHASE_BEGIN(); small_gemm<DFF>(F, wsp<bf16>(F, WS_FF), wsp<bf16>(F, WS_WD), Es);
        {
          LAS int* qslot = (LAS int*)(F.lds + LDSCTL_OFF + 32); unsigned* scnt = (unsigned*)(F.ws + WS_CTL) + CTL_PC + 4096;
          const int mine = F.vcu < 256 ? (256 - F.vcu + F.G - 1) / F.G : 0;
          asm volatile("s_waitcnt vmcnt(0)" ::: "memory"); __syncthreads();
          if (F.tid == 0) { __builtin_amdgcn_fence(__ATOMIC_RELEASE, "agent"); const unsigned old = xb_add(scnt, (unsigned)mine); const bool last = mine > 0 && old + (unsigned)mine == 256u;
              if (last) { __builtin_amdgcn_fence(__ATOMIC_ACQUIRE, "agent"); asm volatile("s_waitcnt vmcnt(0)" ::: "memory"); } *qslot = last ? 1 : 0; }
          __syncthreads();
          if (*qslot) { const float* X2 = wsp<float>(F, WS_PT); float* Y = F.out; rms_rows<true>(T + 16 * F.wave, 1, T + 16 * F.wave + 16, [&](int m) { return X2 + (size_t)m * DM; }, [&](int m) { return Y + (size_t)m * DM; }, ((const float*)F.A.in[28]), F.lane); }
          __syncthreads(); }
        EpiFinal E{wsp<float>(F, WS_X1), F.out, ((const float*)F.A.in[28]), (float*)(F.ws + WS_XS), (unsigned*)(F.ws + WS_CTL) + CTL_PC};
        pg8::gemm_phase<EpiFinal, SchedOne, true, true>(F.lds, DFF, S, E);
    }
#undef IN
#undef SEAM
}

#ifndef MK_SPLIT
#define MK_SPLIT 0
#endif
extern "C" void kernel_launch(void* const* d_in, const int* in_sizes, int n_in, void* d_out, int out_size, void* d_ws, size_t ws_size, hipStream_t stream) {
    static int grid = 0;
    if (grid == 0) {
        if (n_in != 29 || out_size != (int)O_END || ws_size < WS_END) { fprintf(stderr, "kernel_launch: unexpected shapes: n_in %d out %d ws %zu (need %zu)\n", n_in, out_size, ws_size, (size_t)WS_END); grid = -1; return; }
        int dev = 0, cus = 0, per_cu = 0;
        if (hipGetDevice(&dev) != hipSuccess || hipDeviceGetAttribute(&cus, hipDeviceAttributeMultiprocessorCount, dev) != hipSuccess) { grid = -1; return; }
        if (hipFuncSetAttribute((const void*)mk_fwd, hipFuncAttributeMaxDynamicSharedMemorySize, LDS_BYTES) != hipSuccess) { fprintf(stderr, "kernel_launch: hipFuncSetAttribute failed\n"); grid = -1; return; }
        if (hipOccupancyMaxActiveBlocksPerMultiprocessor(&per_cu, (const void*)mk_fwd, 512, LDS_BYTES) != hipSuccess || per_cu < 1) fprintf(stderr, "kernel_launch: occupancy query reports %d\n", per_cu);
        (void)hipGetLastError();
        grid = cus;
    }
    if (grid < 0) return;
    (void)hipMemsetAsync((char*)d_ws + WS_CTL, 0, CTL_ZERO_BYTES, stream);
    Args a{};
    for (int i = 0; i < 29; ++i) a.in[i] = d_in[i];
    a.out = (float*)d_out; a.ws = (unsigned char*)d_ws;
#if MK_SPLIT
    for (int p = 0; p < NPHASE; ++p) { a.ph_lo = p; a.ph_hi = p + 1; hipLaunchKernelGGL(mk_fwd, dim3(grid), dim3(512), LDS_BYTES, stream, a); }
#else
    a.ph_lo = 0; a.ph_hi = NPHASE; hipLaunchKernelGGL(mk_fwd, dim3(grid), dim3(512), LDS_BYTES, stream, a);
#endif
    const hipError_t le = hipPeekAtLastError();
    if (le != hipSuccess) fprintf(stderr, "kernel_launch: launch failed: %s\n", hipGetErrorName(le));
}
```
